# Optimizing an MI355X kernel written in HIP

```python
import math
import jax
import jax.numpy as jnp
from jax import lax
import numpy as np

D_MODEL = 1024
BATCH = 4
SEQ = 4096
DEPTH = 1
DEC_BATCH = 1
DEC_SEQ = 16384
PAST_LEN = 128

GRID_W = 64
N_HEADS = 8
HEAD_DIM = 64
D_ATTN = N_HEADS * HEAD_DIM
WIN_R_MAX = 8
WIN_C = 16
D_HYENA = 512
SHORT_K = 3
FILTER_EMB = 33
FILTER_HIDDEN = 64
FILTER_OUT_SCALE = 0.05
DECAY_TARGET = 1e-2
FAST_DECAY_PCT = 0.3
SLOW_DECAY_PCT = 1.5
D_FF = -(-8 * D_MODEL // (3 * 256)) * 256
D_IN = 3 * D_ATTN + 3 * D_HYENA + 2 * D_MODEL
EPS = 1e-6

kernel_name = 'hybrid_natten_hyena_encoder'


def rmsnorm(x, g):
    xf = x.astype(jnp.float32)
    inv = lax.rsqrt(jnp.mean(xf * xf, axis=-1, keepdims=True) + EPS)
    return (xf * inv).astype(x.dtype) * g


def neighbourhood_attention(q, k, v, rpb):
    b, L = q.shape[0], q.shape[1]
    rows = L // GRID_W
    kr = min(WIN_R_MAX, rows)
    q = q.reshape(b, rows, GRID_W, N_HEADS, HEAD_DIM)
    k = k.reshape(b, rows, GRID_W, N_HEADS, HEAD_DIM)
    v = v.reshape(b, rows, GRID_W, N_HEADS, HEAD_DIM)
    r = jnp.arange(rows)
    row_start = jnp.clip(r - kr // 2, 0, rows - kr)
    key_rows = row_start[:, None] + jnp.arange(kr)[None, :]
    k_blk = k[:, key_rows]
    v_blk = v[:, key_rows]
    c = jnp.arange(GRID_W)
    col_start = jnp.clip(c - WIN_C // 2, 0, GRID_W - WIN_C)
    col_in = (c[None, :] >= col_start[:, None]) & (c[None, :] < col_start[:, None] + WIN_C)
    dr = key_rows - r[:, None] + (WIN_R_MAX - 1)
    dc = jnp.clip(c[None, :] - c[:, None], -(WIN_C - 1), WIN_C - 1) + (WIN_C - 1)
    bias = rpb[:, dr[:, None, :, None], dc[None, :, None, :]]
    bias = jnp.transpose(bias, (1, 0, 2, 3, 4)).astype(jnp.float32)
    s = jnp.einsum('brqhd,brikhd->brhqik', q, k_blk, preferred_element_type=jnp.float32)
    s = s * (HEAD_DIM ** -0.5) + bias
    s = jnp.where(col_in[:, None, :], s, -jnp.inf)
    p = jax.nn.softmax(s.reshape(s.shape[:4] + (kr * GRID_W,)), axis=-1).reshape(s.shape)
    o = jnp.einsum('brhqik,brikhd->brqhd', p.astype(v.dtype), v_blk)
    return o.reshape(b, L, D_ATTN)


def short_conv(x, w, bias):
    L = x.shape[1]
    pad = SHORT_K // 2
    xp = jnp.pad(x, ((0, 0), (pad, SHORT_K - 1 - pad), (0, 0)))
    y = xp[:, 0:L] * w[0]
    for j in range(1, SHORT_K):
        y = y + xp[:, j:j + L] * w[j]
    return y + bias


def implicit_filters(L, w1, b1, w2, b2, w3, b3, w4, freq):
    f32 = jnp.float32
    t = jnp.linspace(0.0, 1.0, L, dtype=f32)[:, None]
    bands = (FILTER_EMB - 1) // 2
    omega = 2.0 * math.pi * jnp.arange(L, dtype=f32) / L
    fb = jnp.linspace(1e-4, bands - 1, bands, dtype=f32)
    ang = omega[:, None] * fb[None, :]
    z = jnp.concatenate([t, jnp.cos(ang), -jnp.sin(ang)], axis=-1)
    fr = freq.astype(f32)
    h = jnp.sin(fr * (z @ w1.astype(f32) + b1.astype(f32)))
    h = jnp.sin(fr * (h @ w2.astype(f32) + b2.astype(f32)))
    h = jnp.sin(fr * (h @ w3.astype(f32) + b3.astype(f32)))
    h = h @ w4.astype(f32)
    max_decay = math.log(DECAY_TARGET) / FAST_DECAY_PCT
    min_decay = math.log(DECAY_TARGET) / SLOW_DECAY_PCT
    deltas = jnp.abs(jnp.linspace(min_decay, max_decay, D_HYENA, dtype=f32))
    decay = jnp.exp(-t * deltas[None, :])
    return h[:, :D_HYENA] * decay, h[:, D_HYENA:] * decay


def bidirectional_fftconv(u, h_fwd, h_bwd, d_skip):
    L = u.shape[1]
    kf = jnp.pad(h_fwd, ((0, L), (0, 0)))
    kb = jnp.concatenate([h_bwd[:1], jnp.zeros((L, D_HYENA), jnp.float32), h_bwd[:0:-1]], axis=0)
    k_f = jnp.fft.rfft(kf + kb, n=2 * L, axis=0)
    uf = u.astype(jnp.float32)
    y = jnp.fft.irfft(jnp.fft.rfft(uf, n=2 * L, axis=1) * k_f[None], n=2 * L, axis=1)[:, :L]
    return (y + uf * d_skip.astype(jnp.float32)).astype(u.dtype)


def hybrid_layer(x, norm_mix, w_in, rpb, conv_w, conv_b, filt_w1, filt_b1, filt_w2, filt_b2,
                 filt_w3, filt_b3, filt_w4, filt_freq, hyena_d, w_br_attn, w_br_hyena, w_out,
                 norm_ffn, w_gate, w_up, w_down):
    b, L, _ = x.shape
    h = rmsnorm(x, norm_mix)
    z = h @ w_in
    q, k, v, hy, g_attn, g_hyena = jnp.split(
        z, [D_ATTN, 2 * D_ATTN, 3 * D_ATTN, 3 * D_ATTN + 3 * D_HYENA,
            3 * D_ATTN + 3 * D_HYENA + D_MODEL], axis=-1)
    heads = (b, L, N_HEADS, HEAD_DIM)
    y_attn = neighbourhood_attention(q.reshape(heads), k.reshape(heads), v.reshape(heads), rpb)
    hy = short_conv(hy, conv_w, conv_b)
    x0, x1, hv = jnp.split(hy, 3, axis=-1)
    h_fwd, h_bwd = implicit_filters(L, filt_w1, filt_b1, filt_w2, filt_b2, filt_w3, filt_b3,
                                    filt_w4, filt_freq)
    y_hyena = x0 * bidirectional_fftconv(x1 * hv, h_fwd, h_bwd, hyena_d)
    merged = (jax.nn.sigmoid(g_attn) * (y_attn @ w_br_attn)
              + jax.nn.sigmoid(g_hyena) * (y_hyena @ w_br_hyena))
    x = x + merged @ w_out
    h = rmsnorm(x, norm_ffn)
    x = x + (jax.nn.silu(h @ w_gate) * (h @ w_up)) @ w_down
    return x


def trunk(x, norm_mix, w_in, rpb, conv_w, conv_b, filt_w1, filt_b1, filt_w2, filt_b2,
          filt_w3, filt_b3, filt_w4, filt_freq, hyena_d, w_br_attn, w_br_hyena, w_out,
          norm_ffn, w_gate, w_up, w_down, norm_final):
    for l in range(DEPTH):
        x = hybrid_layer(x, norm_mix[l], w_in[l], rpb[l], conv_w[l], conv_b[l],
                         filt_w1[l], filt_b1[l], filt_w2[l], filt_b2[l], filt_w3[l], filt_b3[l],
                         filt_w4[l], filt_freq[l], hyena_d[l], w_br_attn[l], w_br_hyena[l],
                         w_out[l], norm_ffn[l], w_gate[l], w_up[l], w_down[l])
    return rmsnorm(x, norm_final)


def setup_inputs(seed: int = 0) -> dict:
    key = jax.random.key(seed)
    ks = jax.random.split(key, 24)

    def nrm(k, shape, scale):
        return jax.random.normal(k, shape, jnp.float32) * scale

    return {
        'x_prompt': nrm(ks[0], (BATCH, SEQ, D_MODEL), 1.0),
        'x_sample': nrm(ks[1], (DEC_BATCH, DEC_SEQ, D_MODEL), 1.0),
        'norm_mix': 1.0 + nrm(ks[2], (DEPTH, D_MODEL), 0.01),
        'w_in': nrm(ks[3], (DEPTH, D_MODEL, D_IN), D_MODEL ** -0.5),
        'rpb': nrm(ks[4], (DEPTH, N_HEADS, 2 * WIN_R_MAX - 1, 2 * WIN_C - 1), 0.02),
        'conv_w': nrm(ks[5], (DEPTH, SHORT_K, 3 * D_HYENA), SHORT_K ** -0.5),
        'conv_b': nrm(ks[6], (DEPTH, 3 * D_HYENA), 0.01),
        'filt_w1': nrm(ks[7], (DEPTH, FILTER_EMB, FILTER_HIDDEN), FILTER_EMB ** -0.5),
        'filt_b1': nrm(ks[8], (DEPTH, FILTER_HIDDEN), 0.1),
        'filt_w2': nrm(ks[9], (DEPTH, FILTER_HIDDEN, FILTER_HIDDEN), FILTER_HIDDEN ** -0.5),
        'filt_b2': nrm(ks[10], (DEPTH, FILTER_HIDDEN), 0.1),
        'filt_w3': nrm(ks[11], (DEPTH, FILTER_HIDDEN, FILTER_HIDDEN), FILTER_HIDDEN ** -0.5),
        'filt_b3': nrm(ks[12], (DEPTH, FILTER_HIDDEN), 0.1),
        'filt_w4': nrm(ks[13], (DEPTH, FILTER_HIDDEN, 2 * D_HYENA), FILTER_HIDDEN ** -0.5 * FILTER_OUT_SCALE),
        'filt_freq': 1.0 + nrm(ks[14], (DEPTH, FILTER_HIDDEN), 0.01),
        'hyena_d': nrm(ks[15], (DEPTH, D_HYENA), 1.0),
        'w_br_attn': nrm(ks[16], (DEPTH, D_ATTN, D_MODEL), D_ATTN ** -0.5),
        'w_br_hyena': nrm(ks[17], (DEPTH, D_HYENA, D_MODEL), D_HYENA ** -0.5),
        'w_out': nrm(ks[18], (DEPTH, D_MODEL, D_MODEL), D_MODEL ** -0.5),
        'norm_ffn': 1.0 + nrm(ks[19], (DEPTH, D_MODEL), 0.01),
        'w_gate': nrm(ks[20], (DEPTH, D_MODEL, D_FF), D_MODEL ** -0.5),
        'w_up': nrm(ks[21], (DEPTH, D_MODEL, D_FF), D_MODEL ** -0.5),
        'w_down': nrm(ks[22], (DEPTH, D_FF, D_MODEL), D_FF ** -0.5),
        'norm_final': 1.0 + nrm(ks[23], (D_MODEL,), 0.01),
    }


def reference(x_prompt, x_sample, norm_mix, w_in, rpb, conv_w, conv_b, filt_w1, filt_b1,
              filt_w2, filt_b2, filt_w3, filt_b3, filt_w4, filt_freq, hyena_d, w_br_attn,
              w_br_hyena, w_out, norm_ffn, w_gate, w_up, w_down, norm_final):
    y_prompt = trunk(x_prompt, norm_mix, w_in, rpb, conv_w, conv_b, filt_w1, filt_b1, filt_w2,
                     filt_b2, filt_w3, filt_b3, filt_w4, filt_freq, hyena_d, w_br_attn,
                     w_br_hyena, w_out, norm_ffn, w_gate, w_up, w_down, norm_final)
    y_sample = trunk(x_sample, norm_mix, w_in, rpb, conv_w, conv_b, filt_w1, filt_b1, filt_w2,
                     filt_b2, filt_w3, filt_b3, filt_w4, filt_freq, hyena_d, w_br_attn,
                     w_br_hyena, w_out, norm_ffn, w_gate, w_up, w_down, norm_final)
    return (y_prompt, y_sample)
```

```cpp
#include <hip/hip_runtime.h>
#include <hip/hip_cooperative_groups.h>
#include <cstdio>
#include <cstdint>
namespace cg = cooperative_groups;
namespace pg8 {
#define PG8_LAS __attribute__((address_space(3)))
typedef unsigned short bf16_t;
typedef short bf16x8 __attribute__((ext_vector_type(8)));
typedef float f32x4 __attribute__((ext_vector_type(4)));
typedef unsigned u32x4 __attribute__((ext_vector_type(4)));
constexpr int BM = 256, BK = 64, HALF = 128, HTB = HALF * BK * 2  , STAGE_BYTES = 8 * HTB, NXCD = 8, WGM = 8;

__host__ __device__ __forceinline__ int lds_byte(int r, int c) { const int st = (r >> 4) * 2 + (c >> 5), rr = r & 15, cc = c & 31, ob = rr * 64 + cc * 2; return st * 1024 + (ob ^ (((ob >> 9) & 1) << 5)); }
__host__ __device__ __forceinline__ void stage_rc(int b, int& R, int& C) { const int st = b / 1024, sb = b % 1024, swz = sb ^ (((sb >> 9) & 1) << 5); R = (st >> 1) * 16 + swz / 64; C = (st & 1) * 32 + (swz % 64) / 2; }
__host__ __device__ __forceinline__ int perm32(int rho) { const int n = rho >> 4, i = rho & 15; return 8 * (i >> 2) + 4 * n + (i & 3); }

struct Unit { int pm, pn; };
struct Gemm { const bf16_t* A; const bf16_t* Bt; int M, N, K; };

struct StaticOrder {
    int nM, nN, nwg, G, c;
    __host__ __device__ void init(int M, int N, int G_, int c_) { nM = M / BM; nN = N / BM; nwg = nM * nN; G = G_; c = c_; }
    __host__ __device__ bool next(int i, Unit& u) const {
        const long L = (long)i * G + c; if (L >= nwg) return false;
        int wgid = (int)L; { const int q = nwg / NXCD, r = nwg % NXCD, xcd = wgid % NXCD, off = wgid / NXCD; wgid = (xcd < r ? xcd * (q + 1) : r * (q + 1) + (xcd - r) * q) + off; }
        const int nig = WGM * nN, gid = wgid / nig, fm = gid * WGM, gsz = (nM - fm) < WGM ? (nM - fm) : WGM;
        u.pm = fm + ((wgid % nig) % gsz); u.pn = (wgid % nig) / gsz; return true;
    }
    __device__ __forceinline__ void a_ready(const Unit&) const {}
    __device__ __forceinline__ void done(const Unit&) const {}
};

__device__ __forceinline__ unsigned cvt_pk_bf16(float lo, float hi) { unsigned r; asm volatile("v_cvt_pk_bf16_f32 %0, %1, %2" : "=v"(r) : "v"(lo), "v"(hi)); return r; }
typedef float f32x2 __attribute__((ext_vector_type(2)));
template <class Epi, class Sched, bool ALIGN_EPI = false, bool SP2 = false>
__device__ __forceinline__ void gemm_phase(PG8_LAS unsigned char* lds, const Gemm g, const Sched& S, const Epi& E) {
    const int tid = threadIdx.x, wid = __builtin_amdgcn_readfirstlane(tid >> 6), lane = tid & 63, wr = wid >> 2, wc = wid & 3, fr = lane & 15, fq = lane >> 4;
    const int K = g.K, nt = K / BK;
    unsigned voffA[2], voffB[2];
#pragma unroll
    for (int i = 0; i < 2; ++i) { int R, C; stage_rc(tid * 16 + i * 8192, R, C); const int Rb = Epi::PERM ? ((R & ~31) + perm32(R & 31)) : R;
        voffA[i] = (unsigned)(R * K + C) * 2u; voffB[i] = (unsigned)(Rb * K + C) * 2u; }
    const size_t kstep = (size_t)(BK * 2);
    const size_t hstep = (size_t)HALF * K * 2;
    const size_t tstep = 2 * hstep;
    const unsigned ldsw = (unsigned)wid * 1024u;
    const int aoff = lds_byte(wr * 64 + fr, fq * 8), boff = lds_byte(wc * 32 + fr, fq * 8);
#define PG8_SA(b, h) (((b) * 2 + (h)) * HTB)
#define PG8_SB(b, h) ((4 + (b) * 2 + (h)) * HTB)
#define PG8_STAGE(bufoff, gbase, voff) do { _Pragma("unroll") for (int _i = 0; _i < 2; ++_i) \
        __builtin_amdgcn_global_load_lds((const unsigned*)((const char*)(gbase) + (voff)[_i]), (PG8_LAS unsigned*)(lds + (bufoff) + ldsw + _i * 8192), 16, 0, 0); } while (0)
#define PG8_LDA(dst, b, h) do { _Pragma("unroll") for (int m = 0; m < 4; ++m) _Pragma("unroll") for (int k = 0; k < 2; ++k) dst[m][k] = *(const PG8_LAS bf16x8*)(lds + PG8_SA(b, h) + aoff + m * 2048 + k * 1024); } while (0)
#define PG8_LDB(dst, b, h) do { _Pragma("unroll") for (int n = 0; n < 2; ++n) _Pragma("unroll") for (int k = 0; k < 2; ++k) dst[n][k] = *(const PG8_LAS bf16x8*)(lds + PG8_SB(b, h) + boff + n * 2048 + k * 1024); } while (0)
#define PG8_MMA(ai, bj, At, Bt) do { __builtin_amdgcn_s_setprio(1); _Pragma("unroll") for (int m = 0; m < 4; ++m) _Pragma("unroll") for (int n = 0; n < 2; ++n) _Pragma("unroll") for (int k = 0; k < 2; ++k) \
        acc[ai][bj][m][n] = __builtin_amdgcn_mfma_f32_16x16x32_bf16(Bt[n][k], At[m][k], acc[ai][bj][m][n], 0, 0, 0); __builtin_amdgcn_s_setprio(0); } while (0)
#define PG8_WAIT_V(n) asm volatile("s_waitcnt vmcnt(" #n ")" ::: "memory")
#define PG8_WAIT_L(n) asm volatile("s_waitcnt lgkmcnt(" #n ")" ::: "memory")
#define PG8_BAR __builtin_amdgcn_s_barrier()
#define PG8_SCHED __builtin_amdgcn_sched_barrier(0)
    Unit cur, nxt; int ui = 0;
    if (!S.next(0, cur)) return;
    f32x4 acc[2][2][4][2];
#pragma unroll
    for (int a = 0; a < 2; ++a)
#pragma unroll
        for (int b = 0; b < 2; ++b)
#pragma unroll
            for (int m = 0; m < 4; ++m)
#pragma unroll
                for (int n = 0; n < 2; ++n) acc[a][b][m][n] = (f32x4){0.f, 0.f, 0.f, 0.f};
    bf16x8 At[4][2], B0[2][2], B1[2][2];
    const char* cA = (const char*)g.A + (size_t)cur.pm * tstep; const char* cB = (const char*)g.Bt + (size_t)cur.pn * tstep;
    S.a_ready(cur);
    if constexpr (SP2) {
        PG8_STAGE(PG8_SB(0, 0), cB, voffB); PG8_STAGE(PG8_SB(0, 1), cB + hstep, voffB); PG8_STAGE(PG8_SA(0, 0), cA, voffA); PG8_STAGE(PG8_SA(0, 1), cA + hstep, voffA);
        if (wr == 1) PG8_BAR;
        PG8_WAIT_V(2); PG8_BAR;
        PG8_STAGE(PG8_SB(1, 0), cB + kstep, voffB); PG8_STAGE(PG8_SA(1, 0), cA + kstep, voffA); PG8_STAGE(PG8_SB(1, 1), cB + hstep + kstep, voffB);
        PG8_WAIT_V(6); PG8_BAR;
    } else {
        PG8_STAGE(PG8_SB(0, 0), cB, voffB); PG8_STAGE(PG8_SA(0, 0), cA, voffA); PG8_STAGE(PG8_SB(0, 1), cB + hstep, voffB); PG8_STAGE(PG8_SA(0, 1), cA + hstep, voffA);
        if (wr == 1) PG8_BAR;
        PG8_WAIT_V(4); PG8_BAR;
        PG8_STAGE(PG8_SB(1, 0), cB + kstep, voffB); PG8_STAGE(PG8_SA(1, 0), cA + kstep, voffA); PG8_STAGE(PG8_SB(1, 1), cB + hstep + kstep, voffB);
        PG8_WAIT_V(6); PG8_BAR;
    }
    for (;;) {
        const bool has_next = S.next(ui + 1, nxt);
        const char* nA = has_next ? (const char*)g.A + (size_t)nxt.pm * tstep : cA; const char* nB = has_next ? (const char*)g.Bt + (size_t)nxt.pn * tstep : cB;
        for (int t = 0; t < nt; t += 2) {
            const bool last = (t == nt - 2);
            const char* a1 = cA + (size_t)(t + 1) * kstep;
            const char* a2 = last ? nA : cA + (size_t)(t + 2) * kstep; const char* b2 = last ? nB : cB + (size_t)(t + 2) * kstep;
            const char* a3 = a2 + kstep; const char* b3 = b2 + kstep;
            if (last && has_next) S.a_ready(nxt);
            if constexpr (SP2) {
            PG8_LDB(B0, 0, 0); PG8_LDB(B1, 0, 1); PG8_SCHED; PG8_LDA(At, 0, 0); PG8_STAGE(PG8_SA(1, 1), a1 + hstep, voffA);
            PG8_WAIT_V(8); PG8_WAIT_L(0); PG8_BAR; PG8_MMA(0, 0, At, B0); PG8_MMA(0, 1, At, B1); PG8_BAR; PG8_SCHED;
            PG8_LDA(At, 0, 1); PG8_STAGE(PG8_SB(0, 0), b2, voffB); PG8_STAGE(PG8_SB(0, 1), b2 + hstep, voffB); PG8_STAGE(PG8_SA(0, 0), a2, voffA);
            PG8_WAIT_V(8); PG8_WAIT_L(0); PG8_BAR; PG8_MMA(1, 0, At, B0); PG8_MMA(1, 1, At, B1); PG8_BAR; PG8_SCHED;
            PG8_LDB(B0, 1, 0); PG8_LDB(B1, 1, 1); PG8_SCHED; PG8_LDA(At, 1, 0); PG8_STAGE(PG8_SA(0, 1), a2 + hstep, voffA);
            PG8_WAIT_V(8); PG8_WAIT_L(0); PG8_BAR; PG8_MMA(0, 0, At, B0); PG8_MMA(0, 1, At, B1); PG8_BAR; PG8_SCHED;
            PG8_LDA(At, 1, 1); PG8_STAGE(PG8_SB(1, 0), b3, voffB); PG8_STAGE(PG8_SB(1, 1), b3 + hstep, voffB); PG8_STAGE(PG8_SA(1, 0), a3, voffA);
            PG8_WAIT_V(8); PG8_WAIT_L(0); PG8_BAR; PG8_MMA(1, 0, At, B0); PG8_MMA(1, 1, At, B1); PG8_BAR; PG8_SCHED;
            } else {
            PG8_LDB(B0, 0, 0); PG8_SCHED; PG8_LDA(At, 0, 0); PG8_STAGE(PG8_SA(1, 1), a1 + hstep, voffA);
            PG8_WAIT_L(8); PG8_BAR; PG8_WAIT_L(0); PG8_MMA(0, 0, At, B0); PG8_BAR; PG8_SCHED;
            PG8_LDB(B1, 0, 1); PG8_STAGE(PG8_SB(0, 0), b2, voffB);
            PG8_BAR; PG8_WAIT_L(0); PG8_MMA(0, 1, At, B1); PG8_BAR;
            PG8_LDA(At, 0, 1); PG8_STAGE(PG8_SA(0, 0), a2, voffA);
            PG8_BAR; PG8_WAIT_L(0); PG8_MMA(1, 0, At, B0); PG8_BAR; PG8_SCHED;
            PG8_STAGE(PG8_SB(0, 1), b2 + hstep, voffB);
            PG8_WAIT_V(6); PG8_BAR; PG8_MMA(1, 1, At, B1); PG8_BAR;
            PG8_LDB(B0, 1, 0); PG8_SCHED; PG8_LDA(At, 1, 0); PG8_STAGE(PG8_SA(0, 1), a2 + hstep, voffA);
            PG8_WAIT_L(8); PG8_BAR; PG8_WAIT_L(0); PG8_MMA(0, 0, At, B0); PG8_BAR; PG8_SCHED;
            PG8_LDB(B1, 1, 1); PG8_STAGE(PG8_SB(1, 0), b3, voffB);
            PG8_BAR; PG8_WAIT_L(0); PG8_MMA(0, 1, At, B1); PG8_BAR;
            PG8_LDA(At, 1, 1); PG8_STAGE(PG8_SA(1, 0), a3, voffA);
            PG8_BAR; PG8_WAIT_L(0); PG8_MMA(1, 0, At, B0); PG8_BAR; PG8_SCHED;
            PG8_STAGE(PG8_SB(1, 1), b3 + hstep, voffB);
            PG8_WAIT_V(6); PG8_BAR; PG8_MMA(1, 1, At, B1); PG8_BAR;
            }
        }
        if constexpr (ALIGN_EPI) { if (wr == 0) PG8_BAR; }
        if constexpr (!Epi::AFTER_DRAIN) { E(acc, cur, wr, wc, fr, fq); S.done(cur); }
        if (!has_next) break;
#pragma unroll
        for (int a = 0; a < 2; ++a)
#pragma unroll
            for (int b = 0; b < 2; ++b)
#pragma unroll
                for (int m = 0; m < 4; ++m)
#pragma unroll
                    for (int n = 0; n < 2; ++n) acc[a][b][m][n] = (f32x4){0.f, 0.f, 0.f, 0.f};
        cur = nxt; cA = nA; cB = nB; ++ui;
        if constexpr (ALIGN_EPI) { if (wr == 1) PG8_BAR; }
    }
    PG8_WAIT_V(0);
    if constexpr (!ALIGN_EPI) { if (wr == 0) PG8_BAR; }
    PG8_BAR;
    if constexpr (Epi::AFTER_DRAIN) { E.fused(acc, cur, wr, wc, fr, fq, lds, wid, lane); S.done(cur); }
#undef PG8_SA
#undef PG8_SB
#undef PG8_STAGE
#undef PG8_LDA
#undef PG8_LDB
#undef PG8_MMA
#undef PG8_WAIT_V
#undef PG8_WAIT_L
#undef PG8_BAR
#undef PG8_SCHED
}
}

#ifndef MK_N_LAUNCHES
#define MK_N_LAUNCHES 1
#endif
constexpr int DM = 1024, MTOK = 32768, TOKP = 16384, DFF = 2816, NIN1 = 3072;
constexpr int NPH = 11;
constexpr float EPSN = 1e-6f;
constexpr size_t MiB = 1u << 20;
constexpr size_t WS_CTL = 0, WS_WIN = 1 * MiB, WS_WBA = 11 * MiB, WS_WBH = 12 * MiB, WS_WO = 13 * MiB, WS_WGU = 15 * MiB, WS_WD = 26 * MiB;
constexpr size_t WS_XB = 32 * MiB, WS_Q = 96 * MiB, WS_K = 128 * MiB, WS_VT = 160 * MiB, WS_FRP = 192 * MiB, WS_FRS = 200 * MiB;
constexpr size_t WS_M1 = 160 * MiB, WS_H = 96 * MiB, WS_END = 256 * MiB;
constexpr size_t OUT_HY = 0, OUT_UT = 96 * MiB, OUT_M2 = 0;
constexpr size_t CTL_SS0 = 0, CTL_SS1 = 128 * 1024, CTL_SS2 = 256 * 1024, CTL_F0 = 384 * 1024, CTL_CNT = 400 * 1024, CTL_BAR = 512 * 1024, CTL_BAR_BYTES = 16384;
constexpr int LDS_BYTES = 147456;

#define LAS __attribute__((address_space(3)))
typedef unsigned short bf16;
typedef unsigned u32x4 __attribute__((ext_vector_type(4)));
typedef unsigned u32x2 __attribute__((ext_vector_type(2)));
typedef float f32x4 __attribute__((ext_vector_type(4)));
typedef float f32x16 __attribute__((ext_vector_type(16)));
typedef short bf16x8 __attribute__((ext_vector_type(8)));
typedef float f32x2_t __attribute__((ext_vector_type(2)));
typedef __bf16 bf16x2_t __attribute__((ext_vector_type(2)));
#define DI __device__ __forceinline__
#define LDS_WAIT() asm volatile("s_waitcnt lgkmcnt(0)" ::: "memory")

DI unsigned pk2(float lo, float hi) { f32x2_t v = {lo, hi}; bf16x2_t b = __builtin_convertvector(v, bf16x2_t); return __builtin_bit_cast(unsigned, b); }
DI bf16 f2bf(float f) { return (bf16)(pk2(f, 0.f) & 0xffffu); }
DI float bf_lo(unsigned w) { return __uint_as_float(w << 16); }
DI float bf_hi(unsigned w) { return __uint_as_float(w & 0xffff0000u); }
DI float sigmoidf_(float x) { return 1.0f / (1.0f + __expf(-x)); }
DI float wave_sum(float v) {
#pragma unroll
    for (int o = 1; o < 64; o <<= 1) v += __shfl_xor(v, o);
    return v;
}
DI u32x4 ld16_l2(const void* p) {
    const unsigned long long* q = (const unsigned long long*)p;
    const unsigned long long a = __hip_atomic_load(q, __ATOMIC_RELAXED, __HIP_MEMORY_SCOPE_AGENT), b = __hip_atomic_load(q + 1, __ATOMIC_RELAXED, __HIP_MEMORY_SCOPE_AGENT);
    u32x4 r; r.x = (unsigned)a; r.y = (unsigned)(a >> 32); r.z = (unsigned)b; r.w = (unsigned)(b >> 32); return r;
}
DI int rot_t(int c, int t) { return (t + 128 * c) & (MTOK - 1); }
DI int crow(int reg, int h) { return (reg & 3) + 8 * (reg >> 2) + 4 * h; }

#ifdef PROBE_DUP
struct Args { const float* in[24]; float* out; unsigned char* ws; int ph_lo, ph_hi, dry, sub; };
#else
struct Args { const float* in[24]; float* out; unsigned char* ws; int ph_lo, ph_hi; };
#endif
struct Frame {
    LAS unsigned char* lds; int tid, lane, wave, G, bid;
    const float *xp, *xs;
};
DI const float* xrow(const Frame& F, int m) { return m < TOKP ? F.xp + (size_t)m * DM : F.xs + (size_t)(m - TOKP) * DM; }

using pg8::Unit; using pg8::BM; using pg8::HALF;
typedef const f32x4 (&AccRef)[2][2][4][2];
struct EpiIn {
    static constexpr bool PERM = true, AFTER_DRAIN = false;
    bf16 *Q, *K, *VT, *HY; const float* SS0;
    DI void operator()(AccRef acc, const Unit& u, int wr, int wc, int fr, int fq) const {
        const int row0 = u.pm * BM + wr * 64 + fr, cb = wc * 32 + 8 * fq, pn = u.pn;
#pragma unroll
        for (int ai = 0; ai < 2; ++ai)
#pragma unroll
            for (int m = 0; m < 4; ++m) {
                const int row = row0 + ai * HALF + m * 16;
                float rs = rsqrtf(SS0[row] * (1.0f / DM) + EPSN); if (pn < 2) rs *= 0.125f;
#pragma unroll
                for (int bj = 0; bj < 2; ++bj) {
                    const f32x4 v0 = acc[ai][bj][m][0] * rs, v1 = acc[ai][bj][m][1] * rs;
                    u32x4 w; w.x = pk2(v0[0], v0[1]); w.y = pk2(v0[2], v0[3]); w.z = pk2(v1[0], v1[1]); w.w = pk2(v1[2], v1[3]);
                    const int ct = bj * HALF + cb;
                    if (pn < 2)      *(u32x4*)(Q + (size_t)row * 512 + pn * 256 + ct) = w;
                    else if (pn < 4) *(u32x4*)(K + (size_t)row * 512 + (pn - 2) * 256 + ct) = w;
                    else if (pn < 6) { const int vc = (pn - 4) * 256 + ct; const unsigned wv[4] = {w.x, w.y, w.z, w.w};
_Pragma("unroll")
                        for (int e = 0; e < 8; ++e) VT[(size_t)(vc + e) * MTOK + rot_t(vc + e, row)] = (bf16)((e & 1) ? (wv[e >> 1] >> 16) : (wv[e >> 1] & 0xffffu)); }
                    else             *(u32x4*)(HY + (size_t)row * 1536 + (pn - 6) * 256 + ct) = w;
                }
            }
    }
};
struct EpiGate {
    static constexpr bool PERM = true, AFTER_DRAIN = false;
    bf16* D; const float* SS0;
    DI void operator()(AccRef acc, const Unit& u, int wr, int wc, int fr, int fq) const {
        const int row0 = u.pm * BM + wr * 64 + fr, col0 = u.pn * BM + wc * 32 + 8 * fq;
#pragma unroll
        for (int ai = 0; ai < 2; ++ai)
#pragma unroll
            for (int m = 0; m < 4; ++m) {
                const int row = row0 + ai * HALF + m * 16; const float rs = rsqrtf(SS0[row] * (1.0f / DM) + EPSN);
#pragma unroll
                for (int bj = 0; bj < 2; ++bj) {
                    const f32x4 v0 = acc[ai][bj][m][0] * rs, v1 = acc[ai][bj][m][1] * rs;
                    u32x4 w; w.x = pk2(sigmoidf_(v0[0]), sigmoidf_(v0[1])); w.y = pk2(sigmoidf_(v0[2]), sigmoidf_(v0[3])); w.z = pk2(sigmoidf_(v1[0]), sigmoidf_(v1[1])); w.w = pk2(sigmoidf_(v1[2]), sigmoidf_(v1[3]));
                    *(u32x4*)(D + (size_t)row * DM + col0 + bj * HALF) = w;
                }
            }
    }
};
template <int MODE> struct EpiMix {
    static constexpr bool PERM = true, AFTER_DRAIN = false;
    bf16* M1; const bf16* M2;
    DI void operator()(AccRef acc, const Unit& u, int wr, int wc, int fr, int fq) const {
        const int row0 = u.pm * BM + wr * 64 + fr, col0 = u.pn * BM + wc * 32 + 8 * fq;
#pragma unroll
        for (int ai = 0; ai < 2; ++ai)
#pragma unroll
            for (int m = 0; m < 4; ++m) {
                const int row = row0 + ai * HALF + m * 16;
#pragma unroll
                for (int bj = 0; bj < 2; ++bj) {
                    const size_t off = (size_t)row * DM + col0 + bj * HALF;
                    const f32x4 v0 = acc[ai][bj][m][0], v1 = acc[ai][bj][m][1];
                    const u32x4 a = ld16_l2(M1 + off); u32x4 w;
                    if (MODE == 0) {
                        w.x = pk2(bf_lo(a.x) * v0[0], bf_hi(a.x) * v0[1]); w.y = pk2(bf_lo(a.y) * v0[2], bf_hi(a.y) * v0[3]);
                        w.z = pk2(bf_lo(a.z) * v1[0], bf_hi(a.z) * v1[1]); w.w = pk2(bf_lo(a.w) * v1[2], bf_hi(a.w) * v1[3]);
                    } else {
                        const u32x4 b = ld16_l2(M2 + off);
                        w.x = pk2(bf_lo(a.x) + bf_lo(b.x) * v0[0], bf_hi(a.x) + bf_hi(b.x) * v0[1]); w.y = pk2(bf_lo(a.y) + bf_lo(b.y) * v0[2], bf_hi(a.y) + bf_hi(b.y) * v0[3]);
                        w.z = pk2(bf_lo(a.z) + bf_lo(b.z) * v1[0], bf_hi(a.z) + bf_hi(b.z) * v1[1]); w.w = pk2(bf_lo(a.w) + bf_lo(b.w) * v1[2], bf_hi(a.w) + bf_hi(b.w) * v1[3]);
                    }
                    *(u32x4*)(M1 + off) = w;
                }
            }
    }
};
template <bool FIRST, bool FUSE> struct EpiRes {
    static constexpr bool PERM = false, AFTER_DRAIN = false;
    const float *xp, *xs; float* out; bf16* XB; float* SS; int rowoff; bool dry; const float* gain; unsigned* cnt;
    DI f32x4 base4(int row, int col) const {
#ifdef RES_FP32_X
        if (FIRST) return *(const f32x4*)((row < TOKP ? xp + (size_t)row * DM : xs + (size_t)(row - TOKP) * DM) + col);
#endif
        const u32x2 w = *(const u32x2*)(XB + (size_t)row * DM + col); return (f32x4){bf_lo(w.x), bf_hi(w.x), bf_lo(w.y), bf_hi(w.y)};
    }
    DI void operator()(AccRef acc, const Unit& u, int wr, int wc, int fr, int fq) const {
        const int row0 = rowoff + u.pm * BM + wr * 64 + fr, col0 = u.pn * BM + wc * 32 + 4 * fq;
#pragma unroll
        for (int ai = 0; ai < 2; ++ai)
#pragma unroll
            for (int m = 0; m < 4; ++m) {
                const int row = row0 + ai * HALF + m * 16; float ss = 0.f;
#pragma unroll
                for (int bj = 0; bj < 2; ++bj)
#pragma unroll
                    for (int n = 0; n < 2; ++n) {
                        const int col = col0 + bj * HALF + n * 16;
                        const f32x4 x = base4(row, col) + acc[ai][bj][m][n];
                        ss += (x[0] * x[0] + x[1] * x[1]) + (x[2] * x[2] + x[3] * x[3]);
                        if (FIRST && !dry) { u32x2 w; w.x = pk2(x[0], x[1]); w.y = pk2(x[2], x[3]); *(u32x2*)(XB + (size_t)row * DM + col) = w; }
                    }
                ss += __shfl_xor(ss, 16); ss += __shfl_xor(ss, 32);
                if (fq == 0 && !dry) unsafeAtomicAdd(SS + row, ss);
            }
        if (FUSE) {
            unsigned* pc = cnt + 16 * ((rowoff >> 8) + u.pm);
            asm volatile("s_waitcnt vmcnt(0)" ::: "memory");
            if ((threadIdx.x & 63) == 0) __hip_atomic_fetch_add(pc, 1u, __ATOMIC_RELAXED, __HIP_MEMORY_SCOPE_AGENT);
            unsigned spins = 0;
            for (;;) { const unsigned v = __hip_atomic_load(pc, __ATOMIC_RELAXED, __HIP_MEMORY_SCOPE_AGENT);
                if ((unsigned)__builtin_amdgcn_readfirstlane(v) >= 32u || ++spins > (1u << 22)) break; __builtin_amdgcn_s_sleep(2); }
            __builtin_amdgcn_fence(__ATOMIC_ACQUIRE, "agent");
#pragma unroll
            for (int ai = 0; ai < 2; ++ai)
#pragma unroll
                for (int m = 0; m < 4; ++m) {
                    const int row = row0 + ai * HALF + m * 16;
                    const float rs = rsqrtf(__hip_atomic_load(SS + row, __ATOMIC_RELAXED, __HIP_MEMORY_SCOPE_AGENT) * (1.0f / DM) + EPSN);
#pragma unroll
                    for (int bj = 0; bj < 2; ++bj)
#pragma unroll
                        for (int n = 0; n < 2; ++n) {
                            const int col = col0 + bj * HALF + n * 16;
                            const f32x4 x = base4(row, col) + acc[ai][bj][m][n];
                            if (!dry) *(f32x4*)(out + (size_t)row * DM + col) = x * rs * *(const f32x4*)(gain + col);
                        }
                }
        }
    }
};
struct EpiSwiglu {
    static constexpr bool PERM = true, AFTER_DRAIN = false;
    bf16* H; const float* SS1;
    DI void operator()(AccRef acc, const Unit& u, int wr, int wc, int fr, int fq) const {
        const int row0 = u.pm * BM + wr * 64 + fr, col0 = u.pn * 128 + wc * 32 + 8 * fq;
#pragma unroll
        for (int ai = 0; ai < 2; ++ai)
#pragma unroll
            for (int m = 0; m < 4; ++m) {
                const int row = row0 + ai * HALF + m * 16; const float rs = rsqrtf(SS1[row] * (1.0f / DM) + EPSN);
                float h[8];
#pragma unroll
                for (int n = 0; n < 2; ++n)
#pragma unroll
                    for (int e = 0; e < 4; ++e) { const float g = acc[ai][0][m][n][e] * rs, up = acc[ai][1][m][n][e] * rs; h[4 * n + e] = g * sigmoidf_(g) * up; }
                u32x4 w; w.x = pk2(h[0], h[1]); w.y = pk2(h[2], h[3]); w.z = pk2(h[4], h[5]); w.w = pk2(h[6], h[7]);
                *(u32x4*)(H + (size_t)row * DFF + col0) = w;
            }
    }
};

DI void p0_transpose_item(const float* W, int K, int N, bf16* WT, const float* gk, int gumode, LAS float* scr, int item, int lane) {
    const int nblk = N / 32, kb = item / nblk, nb = item % nblk, k0 = 64 * kb, n0 = 32 * nb;
    const int drow0 = gumode == 0 ? n0 : ((n0 >> 7) * 256 + (n0 & 127) + (gumode == 2 ? 128 : 0));
#pragma unroll 16
    for (int i = 0; i < 32; ++i) { const int kk = 2 * i + (lane >> 5); float v = W[(size_t)(k0 + kk) * N + n0 + (lane & 31)]; if (gk) v *= gk[k0 + kk]; scr[kk * 33 + (lane & 31)] = v; }
    LDS_WAIT(); asm volatile("" ::: "memory");
    const int c = lane & 7;
#pragma unroll
    for (int j = 0; j < 4; ++j) { const int n = (lane >> 3) + 8 * j; const LAS float* s = scr + (8 * c) * 33 + n;
        u32x4 o; o.x = pk2(s[0 * 33], s[1 * 33]); o.y = pk2(s[2 * 33], s[3 * 33]); o.z = pk2(s[4 * 33], s[5 * 33]); o.w = pk2(s[6 * 33], s[7 * 33]);
        *(u32x4*)(WT + (size_t)(drow0 + n) * K + k0 + 8 * c) = o; }
    LDS_WAIT(); asm volatile("" ::: "memory");
}
DI float sin_rad(float x) { return __builtin_amdgcn_sinf(x * 0.15915494309189535f); }
constexpr int FLT_WL = 51200;
DI void filter_stage_weights(const Frame& F, const float* w1, const float* b1, const float* w2, const float* b2, const float* w3, const float* b3, const float* freq) {
    LAS float* wl = (LAS float*)(F.lds + FLT_WL);
    for (int i = F.tid; i < 2112; i += 512) wl[i] = w1[i];
    for (int i = F.tid; i < 4096; i += 512) { wl[2112 + i] = w2[i]; wl[6208 + i] = w3[i]; }
    if (F.tid < 64) { wl[10304 + F.tid] = b1[F.tid]; wl[10368 + F.tid] = b2[F.tid]; wl[10432 + F.tid] = b3[F.tid]; wl[10496 + F.tid] = freq[F.tid]; }
    __syncthreads();
}
DI void filter_unit(const Frame& F, int L, int p0, bf16* FR, float* F0, const float* w4) {
    const LAS float* w1 = (const LAS float*)(F.lds + FLT_WL); const LAS float* w2 = w1 + 2112; const LAS float* w3 = w1 + 6208;
    const LAS float* b1 = w1 + 10304; const LAS float* b2 = w1 + 10368; const LAS float* b3 = w1 + 10432; const LAS float* freq = w1 + 10496;
    LAS float* zs = (LAS float*)F.lds;
    LAS float* hA = (LAS float*)(F.lds + 8448);
    LAS float* hB = (LAS float*)(F.lds + 8448 + 16384);
    LAS unsigned char* H3 = F.lds + 8448 + 32768;
    const int p = F.lane, g = F.wave, pos = p0 + p;
    {
        if (g == 0) zs[p] = (float)pos / (float)(L - 1);
#pragma unroll
        for (int ii = 0; ii < 2; ++ii) { const int i = 2 * g + ii; const float fb = 1e-4f + (float)i * ((15.0f - 1e-4f) / 15.0f);
            float x = (float)pos * fb / (float)L; x = x - floorf(x);
            zs[(1 + i) * 64 + p] = __builtin_amdgcn_cosf(x); zs[(17 + i) * 64 + p] = -__builtin_amdgcn_sinf(x); }
    }
    __syncthreads();
    float fq8[8];
#pragma unroll
    for (int j = 0; j < 8; ++j) fq8[j] = freq[8 * g + j];
    {
        float a[8];
#pragma unroll
        for (int j = 0; j < 8; ++j) a[j] = b1[8 * g + j];
#pragma unroll 11
        for (int k = 0; k < 33; ++k) { const float z = zs[k * 64 + p]; const f32x4 wa = *(const LAS f32x4*)(w1 + k * 64 + 8 * g), wb = *(const LAS f32x4*)(w1 + k * 64 + 8 * g + 4);
            a[0] += z * wa[0]; a[1] += z * wa[1]; a[2] += z * wa[2]; a[3] += z * wa[3]; a[4] += z * wb[0]; a[5] += z * wb[1]; a[6] += z * wb[2]; a[7] += z * wb[3]; }
#pragma unroll
        for (int j = 0; j < 8; ++j) hA[(8 * g + j) * 64 + p] = sin_rad(fq8[j] * a[j]);
    }
    __syncthreads();
    {
        float a[8];
#pragma unroll
        for (int j = 0; j < 8; ++j) a[j] = b2[8 * g + j];
#pragma unroll 8
        for (int k = 0; k < 64; ++k) { const float z = hA[k * 64 + p]; const f32x4 wa = *(const LAS f32x4*)(w2 + k * 64 + 8 * g), wb = *(const LAS f32x4*)(w2 + k * 64 + 8 * g + 4);
            a[0] += z * wa[0]; a[1] += z * wa[1]; a[2] += z * wa[2]; a[3] += z * wa[3]; a[4] += z * wb[0]; a[5] += z * wb[1]; a[6] += z * wb[2]; a[7] += z * wb[3]; }
#pragma unroll
        for (int j = 0; j < 8; ++j) hB[(8 * g + j) * 64 + p] = sin_rad(fq8[j] * a[j]);
    }
    __syncthreads();
    {
        float a[8];
#pragma unroll
        for (int j = 0; j < 8; ++j) a[j] = b3[8 * g + j];
#pragma unroll 8
        for (int k = 0; k < 64; ++k) { const float z = hB[k * 64 + p]; const f32x4 wa = *(const LAS f32x4*)(w3 + k * 64 + 8 * g), wb = *(const LAS f32x4*)(w3 + k * 64 + 8 * g + 4);
            a[0] += z * wa[0]; a[1] += z * wa[1]; a[2] += z * wa[2]; a[3] += z * wa[3]; a[4] += z * wb[0]; a[5] += z * wb[1]; a[6] += z * wb[2]; a[7] += z * wb[3]; }
        u32x4 w; w.x = pk2(sin_rad(fq8[0] * a[0]), sin_rad(fq8[1] * a[1])); w.y = pk2(sin_rad(fq8[2] * a[2]), sin_rad(fq8[3] * a[3]));
        w.z = pk2(sin_rad(fq8[4] * a[4]), sin_rad(fq8[5] * a[5])); w.w = pk2(sin_rad(fq8[6] * a[6]), sin_rad(fq8[7] * a[7]));
        *(LAS u32x4*)(H3 + p * 144 + 16 * g) = w;
    }
    __syncthreads();
    const int r32 = F.lane & 31, hh = F.lane >> 5;
    bf16x8 bfr[2][4];
#pragma unroll
    for (int pt = 0; pt < 2; ++pt)
#pragma unroll
        for (int s = 0; s < 4; ++s) bfr[pt][s] = *(const LAS bf16x8*)(H3 + (32 * pt + r32) * 144 + (16 * s + 8 * hh) * 2);
    const float mind = -3.0701134573253945f, maxd = -15.350567286626972f;
    const int dir = g >> 2;
    for (int cti = 0; cti < 4; ++cti) {
        const int ct = 4 * g + cti;
        f32x16 acc0, acc1;
#pragma unroll
        for (int i = 0; i < 16; ++i) { acc0[i] = 0.f; acc1[i] = 0.f; }
#pragma unroll
        for (int s = 0; s < 4; ++s) {
            const float* wp = w4 + (size_t)(16 * s + 8 * hh) * 1024 + 32 * ct + r32;
            u32x4 aw; aw.x = pk2(wp[0], wp[1024]); aw.y = pk2(wp[2048], wp[3072]); aw.z = pk2(wp[4096], wp[5120]); aw.w = pk2(wp[6144], wp[7168]);
            const bf16x8 af = __builtin_bit_cast(bf16x8, aw);
            acc0 = __builtin_amdgcn_mfma_f32_32x32x16_bf16(af, bfr[0][s], acc0, 0, 0, 0);
            acc1 = __builtin_amdgcn_mfma_f32_32x32x16_bf16(af, bfr[1][s], acc1, 0, 0, 0);
        }
#pragma unroll
        for (int pt = 0; pt < 2; ++pt) {
            const int ps = p0 + 32 * pt + r32; const float tpos = (float)ps / (float)(L - 1);
#pragma unroll
            for (int i = 0; i < 16; ++i) {
                const int c = (32 * ct + crow(i, hh)) & 511;
                const float delta = fabsf(mind + (float)c * ((maxd - mind) / 511.0f));
                const float val = (pt == 0 ? acc0[i] : acc1[i]) * __expf(-tpos * delta);
                bf16* row = FR + (size_t)c * 2 * L;
                if (ps == 0) { F0[dir * 512 + c] = val; if (dir == 0) row[0] = 0; }
                else row[dir ? L + ps : L - ps] = f2bf(val);
            }
        }
    }
    __syncthreads();
}

DI void conv3_load(const bf16* HY, int tok, int col, bool hp, bool hn, u32x4& a, u32x4& b, u32x4& c) {
    const u32x4 z = {0u, 0u, 0u, 0u};
    const bf16* p = HY + (size_t)tok * 1536 + col;
    b = *(const u32x4*)p; a = hp ? *(const u32x4*)(p - 1536) : z; c = hn ? *(const u32x4*)(p + 1536) : z;
}
DI void conv3_apply(const u32x4& a, const u32x4& b, const u32x4& c, const float* cw, const float* cb, int col, float* o) {
    float w0[8], w1[8], w2[8], bb[8];
    *(f32x4*)(w0) = *(const f32x4*)(cw + col); *(f32x4*)(w0 + 4) = *(const f32x4*)(cw + col + 4);
    *(f32x4*)(w1) = *(const f32x4*)(cw + 1536 + col); *(f32x4*)(w1 + 4) = *(const f32x4*)(cw + 1536 + col + 4);
    *(f32x4*)(w2) = *(const f32x4*)(cw + 3072 + col); *(f32x4*)(w2 + 4) = *(const f32x4*)(cw + 3072 + col + 4);
    *(f32x4*)(bb) = *(const f32x4*)(cb + col); *(f32x4*)(bb + 4) = *(const f32x4*)(cb + col + 4);
#pragma unroll
    for (int d = 0; d < 4; ++d) {
        o[2 * d]     = w0[2 * d] * bf_lo(a[d]) + w1[2 * d] * bf_lo(b[d]) + w2[2 * d] * bf_lo(c[d]) + bb[2 * d];
        o[2 * d + 1] = w0[2 * d + 1] * bf_hi(a[d]) + w1[2 * d + 1] * bf_hi(b[d]) + w2[2 * d + 1] * bf_hi(c[d]) + bb[2 * d + 1];
    }
}
DI void tok_edges(int tok, bool& hp, bool& hn) {
    const int tp = tok < TOKP ? (tok & 4095) : tok - TOKP, Ls = tok < TOKP ? 4096 : 16384;
    hp = tp > 0; hn = tp < Ls - 1;
}
struct ConvW { float w0[8], w1[8], w2[8], bb[8]; };
DI void conv3_w(ConvW& W, const float* cw, const float* cb, int col) {
    *(f32x4*)(W.w0) = *(const f32x4*)(cw + col); *(f32x4*)(W.w0 + 4) = *(const f32x4*)(cw + col + 4);
    *(f32x4*)(W.w1) = *(const f32x4*)(cw + 1536 + col); *(f32x4*)(W.w1 + 4) = *(const f32x4*)(cw + 1536 + col + 4);
    *(f32x4*)(W.w2) = *(const f32x4*)(cw + 3072 + col); *(f32x4*)(W.w2 + 4) = *(const f32x4*)(cw + 3072 + col + 4);
    *(f32x4*)(W.bb) = *(const f32x4*)(cb + col); *(f32x4*)(W.bb + 4) = *(const f32x4*)(cb + col + 4);
}
DI void conv3_do(const ConvW& W, const u32x4& a, const u32x4& b, const u32x4& c, float* o) {
#pragma unroll
    for (int d = 0; d < 4; ++d) {
        o[2 * d]     = W.w0[2 * d] * bf_lo(a[d]) + W.w1[2 * d] * bf_lo(b[d]) + W.w2[2 * d] * bf_lo(c[d]) + W.bb[2 * d];
        o[2 * d + 1] = W.w0[2 * d + 1] * bf_hi(a[d]) + W.w1[2 * d + 1] * bf_hi(b[d]) + W.w2[2 * d + 1] * bf_hi(c[d]) + W.bb[2 * d + 1];
    }
}
constexpr int TR_ROW = 272;
DI void p2b_unit(const Frame& F, int unit, const bf16* HY, bf16* UT, const float* cw, const float* cb) {
    const int tt = unit >> 3, cgp = unit & 7;
    LAS unsigned char* T = F.lds;
    { const int t0 = F.tid >> 3, cc = (F.tid & 7) * 8, c0 = cgp * 64 + cc;
      u32x4 xa[2], xb[2], xc[2], va[2], vb[2], vc[2];
#pragma unroll
      for (int j = 0; j < 2; ++j) { const int tok = tt * 128 + t0 + 64 * j; bool hp, hn; tok_edges(tok, hp, hn);
          conv3_load(HY, tok, 512 + c0, hp, hn, xa[j], xb[j], xc[j]); conv3_load(HY, tok, 1024 + c0, hp, hn, va[j], vb[j], vc[j]); }
      ConvW W1, WV; conv3_w(W1, cw, cb, 512 + c0); conv3_w(WV, cw, cb, 1024 + c0);
#pragma unroll
      for (int j = 0; j < 2; ++j) { float x1[8], hv[8]; conv3_do(W1, xa[j], xb[j], xc[j], x1); conv3_do(WV, va[j], vb[j], vc[j], hv);
#pragma unroll
          for (int e = 0; e < 8; ++e) *(LAS bf16*)(T + (cc + e) * TR_ROW + (t0 + 64 * j) * 2) = f2bf(x1[e] * hv[e]); } }
    __syncthreads();
    { const int c = F.tid >> 3, cg = cgp * 64 + c;
#pragma unroll
      for (int j = 0; j < 2; ++j) { const int tch = (F.tid & 7) * 8 + 64 * j;
          *(u32x4*)(UT + (size_t)cg * MTOK + rot_t(cg, tt * 128 + tch)) = *(const LAS u32x4*)(T + c * TR_ROW + tch * 2); } }
    __syncthreads();
}
DI void p2d_unit(const Frame& F, int unit, const bf16* HY, const bf16* YT, bf16* YH, const float* cw, const float* cb) {
    const int tt = unit >> 3, cgp = unit & 7;
    LAS unsigned char* T = F.lds;
    const int t0 = F.tid >> 3, cc = (F.tid & 7) * 8, c0 = cgp * 64 + cc;
    u32x4 xa[2], xb[2], xc[2];
#pragma unroll
    for (int j = 0; j < 2; ++j) { const int tok = tt * 128 + t0 + 64 * j; bool hp, hn; tok_edges(tok, hp, hn); conv3_load(HY, tok, c0, hp, hn, xa[j], xb[j], xc[j]); }
    { const int c = F.tid >> 3, cg = cgp * 64 + c;
#pragma unroll
      for (int j = 0; j < 2; ++j) { const int tch = (F.tid & 7) * 8 + 64 * j;
          *(LAS u32x4*)(T + c * TR_ROW + tch * 2) = *(const u32x4*)(YT + (size_t)cg * MTOK + rot_t(cg, tt * 128 + tch)); } }
    __syncthreads();
    { ConvW W0; conv3_w(W0, cw, cb, c0);
#pragma unroll
      for (int j = 0; j < 2; ++j) { const int t = t0 + 64 * j, tok = tt * 128 + t; float x0[8], y[8]; conv3_do(W0, xa[j], xb[j], xc[j], x0);
#pragma unroll
          for (int e = 0; e < 8; ++e) y[e] = __uint_as_float((unsigned)(*(const LAS bf16*)(T + (cc + e) * TR_ROW + t * 2)) << 16) * x0[e];
          u32x4 w; w.x = pk2(y[0], y[1]); w.y = pk2(y[2], y[3]); w.z = pk2(y[4], y[5]); w.w = pk2(y[6], y[7]);
          *(u32x4*)(YH + (size_t)tok * 512 + c0) = w; } }
    __syncthreads();
}

DI u32x4 shift8(const u32x4 lo, const u32x4 hi, int e) {
    u32x4 r;
    const int ds = e >> 1;
    unsigned w0, w1, w2, w3, w4;
    if (ds == 0) { w0 = lo.x; w1 = lo.y; w2 = lo.z; w3 = lo.w; w4 = hi.x; }
    else if (ds == 1) { w0 = lo.y; w1 = lo.z; w2 = lo.w; w3 = hi.x; w4 = hi.y; }
    else if (ds == 2) { w0 = lo.z; w1 = lo.w; w2 = hi.x; w3 = hi.y; w4 = hi.z; }
    else { w0 = lo.w; w1 = hi.x; w2 = hi.y; w3 = hi.z; w4 = hi.w; }
    if (e & 1) { r.x = __builtin_amdgcn_alignbit(w1, w0, 16); r.y = __builtin_amdgcn_alignbit(w2, w1, 16); r.z = __builtin_amdgcn_alignbit(w3, w2, 16); r.w = __builtin_amdgcn_alignbit(w4, w3, 16); }
    else { r.x = w0; r.y = w1; r.z = w2; r.w = w3; }
    return r;
}
constexpr int CONV_FR_MAX = 2 * 16384 * 2 + 16 * 64;
template <int L, int NB>
DI void conv_unit(const Frame& F, int c, const bf16* FRg, const float* F0, const float* hyD, const bf16* UT, bf16* YT, int tok0, bool dry) {
    constexpr int RS = L / 32, LOGRS = (RS == 512 ? 9 : 7), JB = 32 / NB, WN = (NB == 1 ? 2560 : 640), WCH = WN / 8, WSTEPS = (NB == 1 ? 120 : 24), BST = (NB == 1 ? 5120 : 1408)  ;
    constexpr int NSTEPS = (L + RS) / 16, NWIN = (NSTEPS + WSTEPS - 1) / WSTEPS;
    static_assert(NB * WCH == 320 && WSTEPS % 6 == 0 && (NSTEPS % WSTEPS) % 6 == 0, "window chunks / steps");
    LAS unsigned char* fr = F.lds; LAS unsigned char* uw = F.lds + CONV_FR_MAX + F.wave * 5632;
    const int lane = F.lane, wave = F.wave, r32 = lane & 31, hh = lane >> 5;
    const bf16* ubase = UT + (size_t)c * MTOK;
    const u32x4 z4 = {0u, 0u, 0u, 0u};
    u32x4 lo[5], hi[5];
#define CONV_ISSUE(win) do { const int d0_ = -RS + (win) * WSTEPS * 16; _Pragma("unroll") for (int r_ = 0; r_ < 5; ++r_) { const int cid_ = lane + 64 * r_, b_ = cid_ / WCH, q_ = cid_ % WCH; \
        const int s_ = d0_ + 8 * q_; const int g_ = tok0 + b_ * L + s_; lo[r_] = (s_ >= 0 && s_ < L) ? *(const u32x4*)(ubase + rot_t(c, g_)) : z4; hi[r_] = (s_ + 8 >= 0 && s_ + 8 < L) ? *(const u32x4*)(ubase + rot_t(c, g_ + 8)) : z4; } } while (0)
    CONV_ISSUE(0);
    {
        const bf16* frow = FRg + (size_t)c * 2 * L;
        for (int ch = F.tid; ch < 2 * L / 8; ch += 512) { const u32x4 v = *(const u32x4*)(frow + 8 * ch); const int x0 = 8 * ch; *(LAS u32x4*)(fr + 2 * x0 + ((x0 >> LOGRS) << 4)) = v; }
        __syncthreads();
        if (F.tid == 0) *(LAS bf16*)(fr + 2 * L + ((L >> LOGRS) << 4)) = f2bf(F0[c] + F0[512 + c] + hyD[c]);
        __syncthreads();
    }
    f32x16 acc0, acc1;
#pragma unroll
    for (int i = 0; i < 16; ++i) { acc0[i] = 0.f; acc1[i] = 0.f; }
    const int jj = r32 % JB, bb = r32 / JB;
    const int xA0 = L - RS * r32 + 8 * hh - RS;
    const LAS unsigned char* ubp0 = uw + bb * BST + hh * WN + 16 * jj;
    const LAS unsigned char* ubp1 = uw + bb * BST + (1 - hh) * WN + 16 * (jj + hh);
    for (int win = 0; win < NWIN; ++win) {
        asm volatile("" ::: "memory");
#pragma unroll
        for (int r = 0; r < 5; ++r) { const int cid = lane + 64 * r, b = cid / WCH, q = cid % WCH;
            *(LAS u32x4*)(uw + b * BST + (q & 1) * WN + 16 * (q >> 1)) = shift8(lo[r], hi[r], wave); }
        LDS_WAIT();
        if (win + 1 < NWIN) CONV_ISSUE(win + 1);
        int nst = (NSTEPS - win * WSTEPS) < WSTEPS ? (NSTEPS - win * WSTEPS) : WSTEPS;
#ifdef PROBE_CONV_NOLOOP
        if (dry) nst = 4;
#endif
        const int xw = xA0 + win * WSTEPS * 16;
#define CONV_LD(A_, B0_, B1_, m_) do { const int xA_ = xw + 16 * (m_); A_ = *(const LAS bf16x8*)(fr + 2 * xA_ + ((xA_ >> LOGRS) << 4)); \
            B0_ = *(const LAS bf16x8*)(ubp0 + 16 * (m_)); B1_ = *(const LAS bf16x8*)(ubp1 + 16 * (m_)); } while (0)
#ifdef CONV_SIMPLE
        for (int m = 0; m < nst; ++m) { bf16x8 a_, b0_, b1_; CONV_LD(a_, b0_, b1_, m);
            acc0 = __builtin_amdgcn_mfma_f32_32x32x16_bf16(a_, b0_, acc0, 0, 0, 0);
            acc1 = __builtin_amdgcn_mfma_f32_32x32x16_bf16(a_, b1_, acc1, 0, 0, 0); }
#else
#define CONV_KEEP(k_) asm volatile("" :: "v"(fa[k_][0]), "v"(fb0[k_][0]), "v"(fb1[k_][0]), "v"(fa[k_][1]), "v"(fb0[k_][1]), "v"(fb1[k_][1]))
#define CONV_MM(k_) do { acc0 = __builtin_amdgcn_mfma_f32_32x32x16_bf16(fa[k_][0], fb0[k_][0], acc0, 0, 0, 0); acc1 = __builtin_amdgcn_mfma_f32_32x32x16_bf16(fa[k_][0], fb1[k_][0], acc1, 0, 0, 0); \
                         acc0 = __builtin_amdgcn_mfma_f32_32x32x16_bf16(fa[k_][1], fb0[k_][1], acc0, 0, 0, 0); acc1 = __builtin_amdgcn_mfma_f32_32x32x16_bf16(fa[k_][1], fb1[k_][1], acc1, 0, 0, 0); } while (0)
#define CONV_GLD(k_, g_) do { const int xg_ = xw + 32 * (g_); const LAS unsigned char* pa_ = fr + 2 * xg_ + ((xg_ >> LOGRS) << 4); \
            fa[k_][0] = *(const LAS bf16x8*)pa_; fa[k_][1] = *(const LAS bf16x8*)(pa_ + 32); \
            fb0[k_][0] = *(const LAS bf16x8*)(ubp0 + 32 * (g_)); fb0[k_][1] = *(const LAS bf16x8*)(ubp0 + 32 * (g_) + 16); \
            fb1[k_][0] = *(const LAS bf16x8*)(ubp1 + 32 * (g_)); fb1[k_][1] = *(const LAS bf16x8*)(ubp1 + 32 * (g_) + 16); } while (0)
        bf16x8 fa[3][2], fb0[3][2], fb1[3][2];
        fa[2][0] = (bf16x8){0, 0, 0, 0, 0, 0, 0, 0}; fa[2][1] = fa[2][0]; fb0[2][0] = fa[2][0]; fb0[2][1] = fa[2][0]; fb1[2][0] = fa[2][0]; fb1[2][1] = fa[2][0];
        CONV_GLD(0, 0); CONV_GLD(1, 1);
        const int ng = nst >> 1;
        int g = 0;
        for (; g + 3 < ng; g += 3) {
            CONV_MM(0); CONV_KEEP(2); CONV_GLD(2, g + 2);
            CONV_MM(1); CONV_KEEP(0); CONV_GLD(0, g + 3);
            CONV_MM(2); CONV_KEEP(1); CONV_GLD(1, g + 4);
        }
        CONV_MM(0); CONV_KEEP(2); CONV_GLD(2, g + 2);
        CONV_MM(1); CONV_KEEP(0);
        CONV_MM(2); CONV_KEEP(1);
        CONV_KEEP(2);
#undef CONV_KEEP
#undef CONV_MM
#undef CONV_GLD
#endif
#undef CONV_LD
        LDS_WAIT();
    }
#undef CONV_ISSUE
    __syncthreads();
    LAS bf16* ys = (LAS bf16*)F.lds;
#pragma unroll
    for (int i = 0; i < 16; ++i) { const int t = RS * crow(i, hh) + 16 * jj + wave;
        ys[bb * L + t] = f2bf(acc0[i]); ys[bb * L + t + 8] = f2bf(acc1[i]); }
    __syncthreads();
    if (!dry) for (int ch = F.tid; ch < NB * L / 8; ch += 512) *(u32x4*)(YT + (size_t)c * MTOK + rot_t(c, tok0 + 8 * ch)) = *(const LAS u32x4*)(ys + 8 * ch);
    __syncthreads();
}

constexpr int ATT_KROW = 144, ATT_VROW = 80, ATT_KBYTES = 32 * ATT_KROW, ATT_WAVE_LDS = ATT_KBYTES + 64 * ATT_VROW;
struct AttnRegs { u32x4 k[4], v[4]; };
DI void attn_gload(AttnRegs& R, const bf16* Kb, const bf16* VT, int h, int tokk, int qh, int t, int lane) {
    const int ecol0 = qh ? 24 : 32;
    int ktok, vtok, kstep;
    if (t < 8) { ktok = tokk + 64 * t + 32 * qh + (lane >> 3); kstep = 8; vtok = tokk + 64 * t + 32 * qh + 8 * (lane & 3); }
    else { ktok = tokk + 256 * (t - 8) + ecol0 + (lane >> 3); kstep = 64; vtok = tokk + 256 * (t - 8) + 64 * (lane & 3) + ecol0; }
    const bf16* kp = Kb + (size_t)ktok * 512 + h * 64 + (lane & 7) * 8;
#pragma unroll
    for (int j = 0; j < 4; ++j) R.k[j] = *(const u32x4*)(kp + (size_t)j * kstep * 512);
#pragma unroll
    for (int j = 0; j < 4; ++j) { const int vc = h * 64 + (lane >> 2) + 16 * j; R.v[j] = *(const u32x4*)(VT + (size_t)vc * MTOK + rot_t(vc, vtok)); }
}
DI void attn_stage(const AttnRegs& R, LAS unsigned char* wl, int lane) {
#pragma unroll
    for (int j = 0; j < 4; ++j) *(LAS u32x4*)(wl + ((lane >> 3) + 8 * j) * ATT_KROW + (lane & 7) * 16) = R.k[j];
#pragma unroll
    for (int j = 0; j < 4; ++j) *(LAS u32x4*)(wl + ATT_KBYTES + ((lane >> 2) + 16 * j) * ATT_VROW + (lane & 3) * 16) = R.v[j];
}
struct AttnState { float mrun, lrun; f32x16 o0, o1; };
template <bool COMB> DI void attn_tile(AttnState& st, const LAS unsigned char* wl, const bf16x8 (&qf)[4], const LAS float* tab, int tb, int d0, int r32, int hh) {
    f32x16 S;
#pragma unroll
    for (int i = 0; i < 16; ++i) S[i] = 0.f;
#pragma unroll
    for (int ks = 0; ks < 4; ++ks) { const bf16x8 kf = *(const LAS bf16x8*)(wl + r32 * ATT_KROW + 32 * ks + 16 * hh); S = __builtin_amdgcn_mfma_f32_32x32x16_bf16(kf, qf[ks], S, 0, 0, 0); }
    u32x2 va[2][2][2];
#pragma unroll
    for (int dt = 0; dt < 2; ++dt)
#pragma unroll
        for (int s = 0; s < 2; ++s) { const LAS unsigned char* vp = wl + ATT_KBYTES + (32 * dt + r32) * ATT_VROW + 32 * s + 8 * hh; va[dt][s][0] = *(const LAS u32x2*)vp; va[dt][s][1] = *(const LAS u32x2*)(vp + 16); }
    float sv[16]; float mx = -1e30f;
    const LAS float* tp = tab + 48 + tb;
    float bias[16];
#pragma unroll
    for (int i = 0; i < 16; ++i) bias[i] = tp[COMB ? (i & 3) + 31 * (i >> 2) : (i & 3) + 8 * (i >> 2)];
#pragma unroll
    for (int i = 0; i < 16; ++i) { const int ko = COMB ? (i & 3) : (i & 3) + 8 * (i >> 2); const bool valid = (unsigned)(d0 + ko) < 16u;
        sv[i] = valid ? S[i] + bias[i] : -1e30f; mx = fmaxf(mx, sv[i]); }
    mx = fmaxf(mx, __shfl_xor(mx, 32));
    const float mnew = fmaxf(st.mrun, mx);
    if (__builtin_amdgcn_ballot_w64(mnew > st.mrun) != 0ull) {
        const float scale = __expf(st.mrun - mnew); st.mrun = mnew; st.lrun *= scale;
#pragma unroll
        for (int i = 0; i < 16; ++i) { st.o0[i] *= scale; st.o1[i] *= scale; }
    }
    float ps = 0.f;
#pragma unroll
    for (int i = 0; i < 16; ++i) { const float p = __expf(sv[i] - mnew); sv[i] = p; ps += p; }
    st.lrun += ps;
#pragma unroll
    for (int s = 0; s < 2; ++s) {
        u32x4 pw; pw.x = pk2(sv[8 * s], sv[8 * s + 1]); pw.y = pk2(sv[8 * s + 2], sv[8 * s + 3]); pw.z = pk2(sv[8 * s + 4], sv[8 * s + 5]); pw.w = pk2(sv[8 * s + 6], sv[8 * s + 7]);
        const bf16x8 pb = __builtin_bit_cast(bf16x8, pw);
        u32x4 a0; a0.x = va[0][s][0].x; a0.y = va[0][s][0].y; a0.z = va[0][s][1].x; a0.w = va[0][s][1].y;
        u32x4 a1; a1.x = va[1][s][0].x; a1.y = va[1][s][0].y; a1.z = va[1][s][1].x; a1.w = va[1][s][1].y;
        st.o0 = __builtin_amdgcn_mfma_f32_32x32x16_bf16(__builtin_bit_cast(bf16x8, a0), pb, st.o0, 0, 0, 0);
        st.o1 = __builtin_amdgcn_mfma_f32_32x32x16_bf16(__builtin_bit_cast(bf16x8, a1), pb, st.o1, 0, 0, 0);
    }
}
DI void attn_unit(int grow, int h, int qh, const bf16* Qb, const bf16* Kb, const bf16* VT, bf16* O, const float* rpb, LAS float* tab, LAS unsigned char* wl, int lane, int& cur_head, bool dry) {
    const int r32 = lane & 31, hh = lane >> 5;
    const int g0 = grow < 256 ? (grow & ~63) : 256, rows = grow < 256 ? 64 : 256, r = grow - g0;
    int rs = r - 4; rs = rs < 0 ? 0 : (rs > rows - 8 ? rows - 8 : rs);
    if (cur_head != h) { for (int i = lane; i < 465; i += 64) tab[48 + i] = rpb[h * 465 + i]; cur_head = h; LDS_WAIT(); }
    const int tokq = grow * 64 + 32 * qh + r32;
    const int tokk = (g0 + rs) * 64;
    AttnRegs R;
    attn_gload(R, Kb, VT, h, tokk, qh, 0, lane);
    bf16x8 qf[4];
#pragma unroll
    for (int ks = 0; ks < 4; ++ks) qf[ks] = *(const bf16x8*)(Qb + (size_t)tokq * 512 + h * 64 + 16 * ks + 8 * hh);
    const int c = 32 * qh + r32; int cs = c - 8; cs = cs < 0 ? 0 : (cs > 48 ? 48 : cs);
    asm volatile("" : "+v"(qf[0]), "+v"(qf[1]), "+v"(qf[2]), "+v"(qf[3]));
    AttnState st; st.mrun = -1e20f; st.lrun = 0.f;
#pragma unroll
    for (int i = 0; i < 16; ++i) { st.o0[i] = 0.f; st.o1[i] = 0.f; }
    const int ecol0 = qh ? 24 : 32;
    const int tb0 = (rs - r + 7) * 31 + 15 - c + 4 * hh;
#pragma unroll 1
    for (int it = 0; it < 10; ++it) {
        LDS_WAIT();
        attn_stage(R, wl, lane);
        if (it < 9) attn_gload(R, Kb, VT, h, tokk, qh, it + 1, lane);
        LDS_WAIT();
        if (it < 8) attn_tile<false>(st, wl, qf, tab, tb0 + 31 * it + 32 * qh, 32 * qh + 4 * hh - cs, r32, hh);
        else        attn_tile<true>(st, wl, qf, tab, tb0 + 124 * (it - 8) + ecol0, ecol0 + 4 * hh - cs, r32, hh);
    }
    st.lrun += __shfl_xor(st.lrun, 32);
    const float inv = 1.0f / st.lrun;
    bf16* op = O + (size_t)tokq * 512 + h * 64 + 4 * hh;
    if (!dry)
#pragma unroll
    for (int g = 0; g < 4; ++g) {
        u32x2 w; w.x = pk2(st.o0[4 * g] * inv, st.o0[4 * g + 1] * inv); w.y = pk2(st.o0[4 * g + 2] * inv, st.o0[4 * g + 3] * inv); *(u32x2*)(op + 8 * g) = w;
        u32x2 w2; w2.x = pk2(st.o1[4 * g] * inv, st.o1[4 * g + 1] * inv); w2.y = pk2(st.o1[4 * g + 2] * inv, st.o1[4 * g + 3] * inv); *(u32x2*)(op + 32 + 8 * g) = w2;
    }
}

#define XB_TMO      128
#define XB_XCNT(j)  (256  + 64 * (j))
#define XB_XSUB(j)  (1280 + 64 * (j))
#define XB_XGEN(j)  (2304 + 64 * (j))
#define XB_TOP      3328
#define XB_TOPGEN   3392
#define XCD_BAR_WORDS 3456
#define XB_SPIN_CAP (1u << 18)

__device__ __forceinline__ unsigned xb_ld(unsigned* p)              { return __hip_atomic_load(p, __ATOMIC_RELAXED, __HIP_MEMORY_SCOPE_AGENT); }
__device__ __forceinline__ unsigned xb_add(unsigned* p, unsigned v) { return __hip_atomic_fetch_add(p, v, __ATOMIC_RELAXED, __HIP_MEMORY_SCOPE_AGENT); }
__device__ __forceinline__ unsigned xb_xcc_id() { return (unsigned)__builtin_amdgcn_s_getreg((3 << 11) | 20) & 0xFu; }
#define XB_SPIN(cond, bar) do { unsigned _sp = 0; while (cond) { __builtin_amdgcn_s_sleep(1); \
    if ((++_sp & 255u) == 0u) { if (xb_ld(&(bar)[XB_TMO])) break; if (_sp > XB_SPIN_CAP) { atomicAdd(&(bar)[XB_TMO], 1u); break; } } } } while (0)

struct XcdBarrier {
    unsigned* bar; unsigned x;
    volatile LAS unsigned* st;
};

__device__ __forceinline__ XcdBarrier xcd_barrier_post(unsigned* bar, volatile LAS unsigned* st) {
    XcdBarrier b; b.bar = bar; b.x = xb_xcc_id(); b.st = st;
    if (threadIdx.x == 0) (void)xb_add(&bar[XB_XCNT(b.x)], 1u);
    return b;
}
__device__ __forceinline__ void xcd_barrier_complete(unsigned* bar, unsigned x, unsigned& nloc, unsigned& nx) {
    const unsigned G = gridDim.x * gridDim.y * gridDim.z;
    unsigned sum, cnt, mine, sp = 0u;
    for (;;) {
        sum = 0u; cnt = 0u; mine = 0u;
#pragma unroll
        for (unsigned j = 0; j < 16; ++j) { const unsigned c = xb_ld(&bar[XB_XCNT(j)]); sum += c; cnt += (c > 0u) ? 1u : 0u; mine = (j == x) ? c : mine; }
        if (sum == G) break;
        __builtin_amdgcn_s_sleep(1);
        if ((++sp & 255u) == 0u) { if (xb_ld(&bar[XB_TMO])) break; if (sp > XB_SPIN_CAP) { atomicAdd(&bar[XB_TMO], 1u); break; } }
    }
    nloc = mine > 0u ? mine : 1u; nx = cnt > 0u ? cnt : 1u;
}

__device__ __forceinline__ void xcd_barrier(const XcdBarrier& b) {
    asm volatile("s_waitcnt vmcnt(0)" ::: "memory");
    __syncthreads();
    if (threadIdx.x == 0) {
        unsigned* bar = b.bar;
        __builtin_amdgcn_s_waitcnt(0);
        unsigned nloc = b.st[0], nx = b.st[1];
        if (nloc == 0u) { xcd_barrier_complete(bar, b.x, nloc, nx); b.st[0] = nloc; b.st[1] = nx; }
        const unsigned old = xb_add(&bar[XB_XSUB(b.x)], 1u);
        const unsigned gen = old / nloc;
        if (old + 1u == (gen + 1u) * nloc) {
            __builtin_amdgcn_fence(__ATOMIC_RELEASE, "agent");
            asm volatile("s_waitcnt vmcnt(0)" ::: "memory");
            const unsigned og = xb_add(&bar[XB_TOP], 1u);
            const unsigned tg = og / nx;
            if (og + 1u == (tg + 1u) * nx) xb_add(&bar[XB_TOPGEN], 1u);
            else XB_SPIN(xb_ld(&bar[XB_TOPGEN]) == tg, bar);
            __builtin_amdgcn_fence(__ATOMIC_ACQUIRE, "agent");
            xb_add(&bar[XB_XGEN(b.x)], 1u);
            asm volatile("s_waitcnt vmcnt(0)" ::: "memory");
        } else {
            XB_SPIN(xb_ld(&bar[XB_XGEN(b.x)]) == gen, bar);
            __builtin_amdgcn_fence(__ATOMIC_ACQUIRE, "agent");
            asm volatile("s_waitcnt vmcnt(0)" ::: "memory");
        }
    }
    __syncthreads();
}

__global__ void __launch_bounds__(512, 2) hybrid_fwd(Args args) {
    extern __shared__ __attribute__((aligned(16))) unsigned char lds_raw[];
    Frame F;
    F.lds = (LAS unsigned char*)lds_raw; F.tid = threadIdx.x; F.lane = F.tid & 63; F.wave = __builtin_amdgcn_readfirstlane(F.tid >> 6); F.G = gridDim.x; F.bid = blockIdx.x;
    F.xp = args.in[0]; F.xs = args.in[1];
    unsigned char* ws = args.ws; unsigned char* ob = (unsigned char*)args.out;
    float* SS0 = (float*)(ws + WS_CTL + CTL_SS0); float* SS1 = (float*)(ws + WS_CTL + CTL_SS1); float* SS2 = (float*)(ws + WS_CTL + CTL_SS2); float* F0 = (float*)(ws + WS_CTL + CTL_F0); unsigned* PCNT = (unsigned*)(ws + WS_CTL + CTL_CNT);
    bf16* WIN = (bf16*)(ws + WS_WIN); bf16* WBA = (bf16*)(ws + WS_WBA); bf16* WBH = (bf16*)(ws + WS_WBH); bf16* WO = (bf16*)(ws + WS_WO); bf16* WGU = (bf16*)(ws + WS_WGU); bf16* WD = (bf16*)(ws + WS_WD);
    bf16* XB = (bf16*)(ws + WS_XB); bf16* Qb = (bf16*)(ws + WS_Q); bf16* Kb = (bf16*)(ws + WS_K); bf16* VT = (bf16*)(ws + WS_VT);
    bf16* FRP = (bf16*)(ws + WS_FRP); bf16* FRS = (bf16*)(ws + WS_FRS); bf16* M1 = (bf16*)(ws + WS_M1); bf16* Hb = (bf16*)(ws + WS_H);
    bf16* HY = (bf16*)(ob + OUT_HY); bf16* UT = (bf16*)(ob + OUT_UT); bf16* M2 = (bf16*)(ob + OUT_M2);
    const int lo = args.ph_lo, hi = args.ph_hi;
    const int gw = F.bid * 8 + F.wave, NGW = F.G * 8;
    volatile LAS unsigned* bar_st = (volatile LAS unsigned*)(F.lds + LDS_BYTES - 64);
    if (F.tid < 2) bar_st[F.tid] = 0u;
    __syncthreads();
    XcdBarrier xbar = xcd_barrier_post((unsigned*)(ws + WS_CTL + CTL_BAR), bar_st);
    if (lo > hi) { asm volatile("s_waitcnt vmcnt(0)" ::: "memory"); cg::this_grid().sync(); }
#ifndef PHASE_MASK
#define PHASE_MASK 0xfff
#endif
#define IN(k) (((PHASE_MASK >> (k)) & 1) && lo <= (k) && (k) < hi)
#define GRIDSYNC() do { asm volatile("s_waitcnt vmcnt(0)" ::: "memory"); cg::this_grid().sync(); } while (0)
#define XSYNC() xcd_barrier(xbar)
#ifdef PROBE_DUP
#define DUP_BEGIN(k) { const bool dry = args.dry != 0; const int sub = args.dry ? args.sub : 3; (void)sub;
#define DUP_END(k) }
#else
#define DUP_BEGIN(k) { constexpr bool dry = false; constexpr int sub = 3; (void)sub;
#define DUP_END(k) }
#endif
#define SEAM(k) do { if (IN(k) && IN((k) + 1)) XSYNC(); } while (0)

    DUP_BEGIN(0) if (IN(0)) {
        LAS float* scr = (LAS float*)(F.lds + F.wave * 16384);
        const float* nmix = args.in[2]; const float* nffn = args.in[19];
        constexpr int I_IN = 16 * 160, I_BR = 8 * 32, I_O = 16 * 32, I_G = 16 * 88, I_D = 44 * 32;
        constexpr int NITEMS = I_IN + 2 * I_BR + I_O + 2 * I_G + I_D;
        if (sub & 1) for (int it = gw; it < NITEMS; it += NGW) {
            int r = it;
            if (r < I_IN) { p0_transpose_item(args.in[3], 1024, 5120, WIN, nmix, 0, scr, r, F.lane); continue; } r -= I_IN;
            if (r < I_BR) { p0_transpose_item(args.in[16], 512, 1024, WBA, nullptr, 0, scr, r, F.lane); continue; } r -= I_BR;
            if (r < I_BR) { p0_transpose_item(args.in[17], 512, 1024, WBH, nullptr, 0, scr, r, F.lane); continue; } r -= I_BR;
            if (r < I_O) { p0_transpose_item(args.in[18], 1024, 1024, WO, nullptr, 0, scr, r, F.lane); continue; } r -= I_O;
            if (r < I_G) { p0_transpose_item(args.in[20], 1024, DFF, WGU, nffn, 1, scr, r, F.lane); continue; } r -= I_G;
            if (r < I_G) { p0_transpose_item(args.in[21], 1024, DFF, WGU, nffn, 2, scr, r, F.lane); continue; } r -= I_G;
            p0_transpose_item(args.in[22], DFF, 1024, WD, nullptr, 0, scr, r, F.lane);
        }
        if (sub & 2) for (int m = gw; m < MTOK; m += 4 * NGW) {
            f32x4 v[4][4];
#pragma unroll
            for (int q = 0; q < 4; ++q) { const f32x4* xr = (const f32x4*)xrow(F, m + q * NGW) + F.lane;
#pragma unroll
                for (int j = 0; j < 4; ++j) v[q][j] = xr[64 * j]; }
#pragma unroll
            for (int q = 0; q < 4; ++q) { float s = 0.f;
#pragma unroll
                for (int j = 0; j < 4; ++j) s += (v[q][j].x * v[q][j].x + v[q][j].y * v[q][j].y) + (v[q][j].z * v[q][j].z + v[q][j].w * v[q][j].w);
                s = wave_sum(s); if (F.lane == 0) SS0[m + q * NGW] = s;
                u32x2* o8 = (u32x2*)(XB + (size_t)(m + q * NGW) * DM) + F.lane;
#pragma unroll
                for (int j = 0; j < 4; ++j) { u32x2 w; w.x = pk2(v[q][j].x, v[q][j].y); w.y = pk2(v[q][j].z, v[q][j].w); o8[64 * j] = w; } }
        }
        for (int i = F.bid * 512 + F.tid; i < 2 * MTOK; i += F.G * 512) SS1[i] = 0.f;
        if (F.bid == 0) for (int i = F.tid; i < 2048; i += 512) PCNT[i] = 0u;
        __syncthreads();
        if (sub == 3 || (sub & 4)) filter_stage_weights(F, args.in[7], args.in[8], args.in[9], args.in[10], args.in[11], args.in[12], args.in[14]);
        if (sub == 3 || (sub & 4)) for (int fu = F.bid; fu < 320; fu += F.G) {
            if (fu < 256) filter_unit(F, 16384, 64 * fu, FRS, F0 + 1024, args.in[13]);
            else filter_unit(F, 4096, 64 * (fu - 256), FRP, F0, args.in[13]);
        }
    }
    DUP_END(0)
    SEAM(0);
    DUP_BEGIN(1) if (IN(1)) {
        pg8::Gemm g{XB, WIN, MTOK, NIN1, DM}; pg8::StaticOrder S; S.init(MTOK, NIN1, F.G, F.bid);
        EpiIn E{Qb, Kb, VT, HY, SS0};
        pg8::gemm_phase<EpiIn, pg8::StaticOrder, true, true>(F.lds, g, S, E);
    }
    DUP_END(1)
    SEAM(1);
    DUP_BEGIN(2) if (IN(2)) { for (int u = F.bid; u < 2048; u += F.G) p2b_unit(F, u, HY, UT, args.in[5], args.in[6]); }
    DUP_END(2)
    SEAM(2);
    DUP_BEGIN(3) if (IN(3)) {
        if (sub & 1) for (int cu = F.bid; cu < 1024; cu += F.G) {
            if (cu < 512) conv_unit<16384, 1>(F, cu, FRS, F0 + 1024, args.in[15], UT, UT, TOKP, dry);
            else conv_unit<4096, 4>(F, cu - 512, FRP, F0, args.in[15], UT, UT, 0, dry);
        }
        __syncthreads();
        int cur_head = -1; LAS float* tab = (LAS float*)(F.lds + F.wave * 2560); LAS unsigned char* wl = F.lds + 20480 + F.wave * ATT_WAVE_LDS;
        if (sub & 2) {
            if ((F.G & 7) == 0) {
                const int h = F.bid & 7, NWV = (F.G >> 3) * 8;
                for (int eb = ((F.bid >> 3) * 8 + F.wave) * 4; eb < 1024; eb += NWV * 4)
                    for (int j = 0; j < 4; ++j) attn_unit((eb + j) >> 1, h, (eb + j) & 1, Qb, Kb, VT, Qb, args.in[4], tab, wl, F.lane, cur_head, dry);
            } else {
                for (int u = gw; u < 8192; u += NGW) attn_unit(u >> 4, (u >> 1) & 7, u & 1, Qb, Kb, VT, Qb, args.in[4], tab, wl, F.lane, cur_head, dry);
            }
        }
    }
    DUP_END(3)
    SEAM(3);
    DUP_BEGIN(4) if (IN(4)) { for (int u = F.bid; u < 2048; u += F.G) p2d_unit(F, u, HY, UT, Kb, args.in[5], args.in[6]); }
    DUP_END(4)
    SEAM(4);
    DUP_BEGIN(5) if (IN(5)) {
        pg8::StaticOrder S; S.init(MTOK, DM, F.G, F.bid);
        { pg8::Gemm g{XB, WIN + (size_t)3072 * DM, MTOK, DM, DM}; EpiGate E{M1, SS0}; pg8::gemm_phase<EpiGate, pg8::StaticOrder, true, true>(F.lds, g, S, E); }
        { pg8::Gemm g{Qb, WBA, MTOK, DM, 512}; EpiMix<0> E{M1, nullptr}; pg8::gemm_phase<EpiMix<0>, pg8::StaticOrder, true, true>(F.lds, g, S, E); }
        { pg8::Gemm g{XB, WIN + (size_t)4096 * DM, MTOK, DM, DM}; EpiGate E{M2, SS0}; pg8::gemm_phase<EpiGate, pg8::StaticOrder, true, true>(F.lds, g, S, E); }
        { pg8::Gemm g{Kb, WBH, MTOK, DM, 512}; EpiMix<1> E{M1, M2}; pg8::gemm_phase<EpiMix<1>, pg8::StaticOrder, true, true>(F.lds, g, S, E); }
    }
    DUP_END(5)
    SEAM(5);
    DUP_BEGIN(6) if (IN(6)) {
        pg8::Gemm g{M1, WO, MTOK, DM, DM}; pg8::StaticOrder S; S.init(MTOK, DM, F.G, F.bid);
        EpiRes<true, false> E{F.xp, F.xs, args.out, XB, SS1, 0, dry, nullptr, nullptr};
        pg8::gemm_phase<EpiRes<true, false>, pg8::StaticOrder, true, true>(F.lds, g, S, E);
    }
    DUP_END(6)
    SEAM(6);
#define FFN_HALF(hf) \
    DUP_BEGIN(7 + 2 * (hf)) if (IN(7 + 2 * (hf))) { \
        pg8::Gemm g{XB + (size_t)(hf) * TOKP * DM, WGU, TOKP, 2 * DFF, DM}; pg8::StaticOrder S; S.init(TOKP, 2 * DFF, F.G, F.bid); \
        EpiSwiglu E{Hb, SS1 + (hf) * TOKP}; \
        pg8::gemm_phase<EpiSwiglu, pg8::StaticOrder, true, true>(F.lds, g, S, E); \
    } DUP_END(7 + 2 * (hf)) \
    SEAM(7 + 2 * (hf)); \
    DUP_BEGIN(8 + 2 * (hf)) if (IN(8 + 2 * (hf))) { \
        pg8::Gemm g{Hb, WD, TOKP, DM, DFF}; pg8::StaticOrder S; S.init(TOKP, DM, F.G, F.bid); \
        EpiRes<false, true> E{nullptr, nullptr, args.out, XB, SS2, (hf) * TOKP, dry, args.in[23], PCNT}; \
        pg8::gemm_phase<EpiRes<false, true>, pg8::StaticOrder, true, true>(F.lds, g, S, E); \
    } DUP_END(8 + 2 * (hf)) \
    SEAM(8 + 2 * (hf));
    FFN_HALF(0)
    FFN_HALF(1)
#undef FFN_HALF
    DUP_BEGIN(11) if (IN(11)) {
        const float* nf = args.in[23];
        for (int m = gw; m < MTOK; m += NGW) {
            const float rs = rsqrtf(SS2[m] * (1.0f / DM) + EPSN);
            f32x4* xr = (f32x4*)(args.out + (size_t)m * DM) + F.lane;
#pragma unroll
            for (int j = 0; j < 4; ++j) { const f32x4 g4 = *((const f32x4*)nf + F.lane + 64 * j); const f32x4 o4 = xr[64 * j] * rs * g4; if (!dry) xr[64 * j] = o4; }
        }
    } DUP_END(11)
#undef IN
#undef SEAM
}

extern "C" void kernel_launch(void* const* d_in, const int* in_sizes, int n_in, void* d_out, int out_size, void* d_ws, size_t ws_size, hipStream_t stream) {
    static int grid = 0;
    if (grid == 0) {
        if (n_in != 24 || out_size != 2 * TOKP * DM || ws_size < WS_END) { fprintf(stderr, "kernel_launch: unexpected shapes (n_in %d out %d ws %zu)\n", n_in, out_size, ws_size); grid = -1; return; }
        int dev = 0, cus = 0, per_cu = 0;
        if (hipGetDevice(&dev) != hipSuccess || hipDeviceGetAttribute(&cus, hipDeviceAttributeMultiprocessorCount, dev) != hipSuccess) { grid = -1; return; }
        if (hipFuncSetAttribute((const void*)hybrid_fwd, hipFuncAttributeMaxDynamicSharedMemorySize, LDS_BYTES) != hipSuccess) { fprintf(stderr, "kernel_launch: hipFuncSetAttribute failed\n"); grid = -1; return; }
        if (hipOccupancyMaxActiveBlocksPerMultiprocessor(&per_cu, (const void*)hybrid_fwd, 512, LDS_BYTES) != hipSuccess || per_cu < 1) { fprintf(stderr, "kernel_launch: occupancy query says %d\n", per_cu); per_cu = 1; }
        (void)hipGetLastError();
        grid = cus * 1;
        if (grid > 256) grid = 256;
    }
    if (grid < 0) return;
    if (hipMemsetAsync((char*)d_ws + WS_CTL + CTL_BAR, 0, CTL_BAR_BYTES, stream) != hipSuccess) { fprintf(stderr, "kernel_launch: memset of barrier words failed\n"); return; }
    Args a{};
    for (int i = 0; i < 24; ++i) a.in[i] = (const float*)d_in[i];
    a.out = (float*)d_out; a.ws = (unsigned char*)d_ws;
#if MK_N_LAUNCHES == 1
    a.ph_lo = 0; a.ph_hi = NPH;
    void* kargs[] = {&a};
    hipError_t e = hipLaunchCooperativeKernel((const void*)hybrid_fwd, dim3(grid), dim3(512), kargs, LDS_BYTES, stream);
    if (e != hipSuccess) fprintf(stderr, "cooperative launch failed: %s (grid %d)\n", hipGetErrorString(e), grid);
#else
    for (int ph = 0; ph < NPH; ++ph) { a.ph_lo = ph; a.ph_hi = ph + 1;
#ifdef PROBE_DUP
        if (ph == PROBE_DUP) { a.dry = 1; a.sub = PROBE_SUB; hipLaunchKernelGGL(hybrid_fwd, dim3(grid), dim3(512), LDS_BYTES, stream, a); a.dry = 0; }
#endif
        hipLaunchKernelGGL(hybrid_fwd, dim3(grid), dim3(512), LDS_BYTES, stream, a); }
#endif
}
```

```cpp
#include <hip/hip_runtime.h>
#include <hip/hip_cooperative_groups.h>
#include <cstdio>
#include <cstdint>
namespace cg = cooperative_groups;
namespace pg8 {
#define PG8_LAS __attribute__((address_space(3)))
typedef unsigned short bf16_t;
typedef short bf16x8 __attribute__((ext_vector_type(8)));
typedef float f32x4 __attribute__((ext_vector_type(4)));
typedef unsigned u32x4 __attribute__((ext_vector_type(4)));
constexpr int BM = 256, BK = 64, HALF = 128, HTB = HALF * BK * 2  , STAGE_BYTES = 8 * HTB, NXCD = 8, WGM = 8;

__host__ __device__ __forceinline__ int lds_byte(int r, int c) { const int st = (r >> 4) * 2 + (c >> 5), rr = r & 15, cc = c & 31, ob = rr * 64 + cc * 2; return st * 1024 + (ob ^ (((ob >> 9) & 1) << 5)); }
__host__ __device__ __forceinline__ void stage_rc(int b, int& R, int& C) { const int st = b / 1024, sb = b % 1024, swz = sb ^ (((sb >> 9) & 1) << 5); R = (st >> 1) * 16 + swz / 64; C = (st & 1) * 32 + (swz % 64) / 2; }
__host__ __device__ __forceinline__ int perm32(int rho) { const int n = rho >> 4, i = rho & 15; return 8 * (i >> 2) + 4 * n + (i & 3); }

struct Unit { int pm, pn; };
struct Gemm { const bf16_t* A; const bf16_t* Bt; int M, N, K; };

struct StaticOrder {
    int nM, nN, nwg, G, c;
    __host__ __device__ void init(int M, int N, int G_, int c_) { nM = M / BM; nN = N / BM; nwg = nM * nN; G = G_; c = c_; }
    __host__ __device__ bool next(int i, Unit& u) const {
        const long L = (long)i * G + c; if (L >= nwg) return false;
        int wgid = (int)L; { const int q = nwg / NXCD, r = nwg % NXCD, xcd = wgid % NXCD, off = wgid / NXCD; wgid = (xcd < r ? xcd * (q + 1) : r * (q + 1) + (xcd - r) * q) + off; }
        const int nig = WGM * nN, gid = wgid / nig, fm = gid * WGM, gsz = (nM - fm) < WGM ? (nM - fm) : WGM;
        u.pm = fm + ((wgid % nig) % gsz); u.pn = (wgid % nig) / gsz; return true;
    }
    __device__ __forceinline__ void a_ready(const Unit&) const {}
    __device__ __forceinline__ void done(const Unit&) const {}
};

__device__ __forceinline__ unsigned cvt_pk_bf16(float lo, float hi) { unsigned r; asm volatile("v_cvt_pk_bf16_f32 %0, %1, %2" : "=v"(r) : "v"(lo), "v"(hi)); return r; }
typedef float f32x2 __attribute__((ext_vector_type(2)));
template <class Epi, class Sched, bool ALIGN_EPI = false, bool SP2 = false>
__device__ __forceinline__ void gemm_phase(PG8_LAS unsigned char* lds, const Gemm g, const Sched& S, const Epi& E) {
    const int tid = threadIdx.x, wid = __builtin_amdgcn_readfirstlane(tid >> 6), lane = tid & 63, wr = wid >> 2, wc = wid & 3, fr = lane & 15, fq = lane >> 4;
    const int K = g.K, nt = K / BK;
    unsigned voffA[2], voffB[2];
#pragma unroll
    for (int i = 0; i < 2; ++i) { int R, C; stage_rc(tid * 16 + i * 8192, R, C); const int Rb = Epi::PERM ? ((R & ~31) + perm32(R & 31)) : R;
        voffA[i] = (unsigned)(R * K + C) * 2u; voffB[i] = (unsigned)(Rb * K + C) * 2u; }
    const size_t kstep = (size_t)(BK * 2);
    const size_t hstep = (size_t)HALF * K * 2;
    const size_t tstep = 2 * hstep;
    const unsigned ldsw = (unsigned)wid * 1024u;
    const int aoff = lds_byte(wr * 64 + fr, fq * 8), boff = lds_byte(wc * 32 + fr, fq * 8);
#define PG8_SA(b, h) (((b) * 2 + (h)) * HTB)
#define PG8_SB(b, h) ((4 + (b) * 2 + (h)) * HTB)
#define PG8_STAGE(bufoff, gbase, voff) do { _Pragma("unroll") for (int _i = 0; _i < 2; ++_i) \
        __builtin_amdgcn_global_load_lds((const unsigned*)((const char*)(gbase) + (voff)[_i]), (PG8_LAS unsigned*)(lds + (bufoff) + ldsw + _i * 8192), 16, 0, 0); } while (0)
#define PG8_LDA(dst, b, h) do { _Pragma("unroll") for (int m = 0; m < 4; ++m) _Pragma("unroll") for (int k = 0; k < 2; ++k) dst[m][k] = *(const PG8_LAS bf16x8*)(lds + PG8_SA(b, h) + aoff + m * 2048 + k * 1024); } while (0)
#define PG8_LDB(dst, b, h) do { _Pragma("unroll") for (int n = 0; n < 2; ++n) _Pragma("unroll") for (int k = 0; k < 2; ++k) dst[n][k] = *(const PG8_LAS bf16x8*)(lds + PG8_SB(b, h) + boff + n * 2048 + k * 1024); } while (0)
#define PG8_MMA(ai, bj, At, Bt) do { __builtin_amdgcn_s_setprio(1); _Pragma("unroll") for (int m = 0; m < 4; ++m) _Pragma("unroll") for (int n = 0; n < 2; ++n) _Pragma("unroll") for (int k = 0; k < 2; ++k) \
        acc[ai][bj][m][n] = __builtin_amdgcn_mfma_f32_16x16x32_bf16(Bt[n][k], At[m][k], acc[ai][bj][m][n], 0, 0, 0); __builtin_amdgcn_s_setprio(0); } while (0)
#define PG8_WAIT_V(n) asm volatile("s_waitcnt vmcnt(" #n ")" ::: "memory")
#define PG8_WAIT_L(n) asm volatile("s_waitcnt lgkmcnt(" #n ")" ::: "memory")
#define PG8_BAR __builtin_amdgcn_s_barrier()
#define PG8_SCHED __builtin_amdgcn_sched_barrier(0)
    Unit cur, nxt; int ui = 0;
    if (!S.next(0, cur)) return;
    f32x4 acc[2][2][4][2];
#pragma unroll
    for (int a = 0; a < 2; ++a)
#pragma unroll
        for (int b = 0; b < 2; ++b)
#pragma unroll
            for (int m = 0; m < 4; ++m)
#pragma unroll
                for (int n = 0; n < 2; ++n) acc[a][b][m][n] = (f32x4){0.f, 0.f, 0.f, 0.f};
    bf16x8 At[4][2], B0[2][2], B1[2][2];
    const char* cA = (const char*)g.A + (size_t)cur.pm * tstep; const char* cB = (const char*)g.Bt + (size_t)cur.pn * tstep;
    S.a_ready(cur);
    if constexpr (SP2) {
        PG8_STAGE(PG8_SB(0, 0), cB, voffB); PG8_STAGE(PG8_SB(0, 1), cB + hstep, voffB); PG8_STAGE(PG8_SA(0, 0), cA, voffA); PG8_STAGE(PG8_SA(0, 1), cA + hstep, voffA);
        if (wr == 1) PG8_BAR;
        PG8_WAIT_V(2); PG8_BAR;
        PG8_STAGE(PG8_SB(1, 0), cB + kstep, voffB); PG8_STAGE(PG8_SA(1, 0), cA + kstep, voffA); PG8_STAGE(PG8_SB(1, 1), cB + hstep + kstep, voffB);
        PG8_WAIT_V(6); PG8_BAR;
    } else {
        PG8_STAGE(PG8_SB(0, 0), cB, voffB); PG8_STAGE(PG8_SA(0, 0), cA, voffA); PG8_STAGE(PG8_SB(0, 1), cB + hstep, voffB); PG8_STAGE(PG8_SA(0, 1), cA + hstep, voffA);
        if (wr == 1) PG8_BAR;
        PG8_WAIT_V(4); PG8_BAR;
        PG8_STAGE(PG8_SB(1, 0), cB + kstep, voffB); PG8_STAGE(PG8_SA(1, 0), cA + kstep, voffA); PG8_STAGE(PG8_SB(1, 1), cB + hstep + kstep, voffB);
        PG8_WAIT_V(6); PG8_BAR;
    }
    for (;;) {
        const bool has_next = S.next(ui + 1, nxt);
        const char* nA = has_next ? (const char*)g.A + (size_t)nxt.pm * tstep : cA; const char* nB = has_next ? (const char*)g.Bt + (size_t)nxt.pn * tstep : cB;
        for (int t = 0; t < nt; t += 2) {
            const bool last = (t == nt - 2);
            const char* a1 = cA + (size_t)(t + 1) * kstep;
            const char* a2 = last ? nA : cA + (size_t)(t + 2) * kstep; const char* b2 = last ? nB : cB + (size_t)(t + 2) * kstep;
            const char* a3 = a2 + kstep; const char* b3 = b2 + kstep;
            if (last && has_next) S.a_ready(nxt);
            if constexpr (SP2) {
            PG8_LDB(B0, 0, 0); PG8_LDB(B1, 0, 1); PG8_SCHED; PG8_LDA(At, 0, 0); PG8_STAGE(PG8_SA(1, 1), a1 + hstep, voffA);
            PG8_WAIT_V(8); PG8_WAIT_L(0); PG8_BAR; PG8_MMA(0, 0, At, B0); PG8_MMA(0, 1, At, B1); PG8_BAR; PG8_SCHED;
            PG8_LDA(At, 0, 1); PG8_STAGE(PG8_SB(0, 0), b2, voffB); PG8_STAGE(PG8_SB(0, 1), b2 + hstep, voffB); PG8_STAGE(PG8_SA(0, 0), a2, voffA);
            PG8_WAIT_V(8); PG8_WAIT_L(0); PG8_BAR; PG8_MMA(1, 0, At, B0); PG8_MMA(1, 1, At, B1); PG8_BAR; PG8_SCHED;
            PG8_LDB(B0, 1, 0); PG8_LDB(B1, 1, 1); PG8_SCHED; PG8_LDA(At, 1, 0); PG8_STAGE(PG8_SA(0, 1), a2 + hstep, voffA);
            PG8_WAIT_V(8); PG8_WAIT_L(0); PG8_BAR; PG8_MMA(0, 0, At, B0); PG8_MMA(0, 1, At, B1); PG8_BAR; PG8_SCHED;
            PG8_LDA(At, 1, 1); PG8_STAGE(PG8_SB(1, 0), b3, voffB); PG8_STAGE(PG8_SB(1, 1), b3 + hstep, voffB); PG8_STAGE(PG8_SA(1, 0), a3, voffA);
            PG8_WAIT_V(8); PG8_WAIT_L(0); PG8_BAR; PG8_MMA(1, 0, At, B0); PG8_MMA(1, 1, At, B1); PG8_BAR; PG8_SCHED;
            } else {
            PG8_LDB(B0, 0, 0); PG8_SCHED; PG8_LDA(At, 0, 0); PG8_STAGE(PG8_SA(1, 1), a1 + hstep, voffA);
            PG8_WAIT_L(8); PG8_BAR; PG8_WAIT_L(0); PG8_MMA(0, 0, At, B0); PG8_BAR; PG8_SCHED;
            PG8_LDB(B1, 0, 1); PG8_STAGE(PG8_SB(0, 0), b2, voffB);
            PG8_BAR; PG8_WAIT_L(0); PG8_MMA(0, 1, At, B1); PG8_BAR;
            PG8_LDA(At, 0, 1); PG8_STAGE(PG8_SA(0, 0), a2, voffA);
            PG8_BAR; PG8_WAIT_L(0); PG8_MMA(1, 0, At, B0); PG8_BAR; PG8_SCHED;
            PG8_STAGE(PG8_SB(0, 1), b2 + hstep, voffB);
            PG8_WAIT_V(6); PG8_BAR; PG8_MMA(1, 1, At, B1); PG8_BAR;
            PG8_LDB(B0, 1, 0); PG8_SCHED; PG8_LDA(At, 1, 0); PG8_STAGE(PG8_SA(0, 1), a2 + hstep, voffA);
            PG8_WAIT_L(8); PG8_BAR; PG8_WAIT_L(0); PG8_MMA(0, 0, At, B0); PG8_BAR; PG8_SCHED;
            PG8_LDB(B1, 1, 1); PG8_STAGE(PG8_SB(1, 0), b3, voffB);
            PG8_BAR; PG8_WAIT_L(0); PG8_MMA(0, 1, At, B1); PG8_BAR;
            PG8_LDA(At, 1, 1); PG8_STAGE(PG8_SA(1, 0), a3, voffA);
            PG8_BAR; PG8_WAIT_L(0); PG8_MMA(1, 0, At, B0); PG8_BAR; PG8_SCHED;
            PG8_STAGE(PG8_SB(1, 1), b3 + hstep, voffB);
            PG8_WAIT_V(6); PG8_BAR; PG8_MMA(1, 1, At, B1); PG8_BAR;
            }
        }
        if constexpr (ALIGN_EPI) { if (wr == 0) PG8_BAR; }
        if constexpr (!Epi::AFTER_DRAIN) { E(acc, cur, wr, wc, fr, fq); S.done(cur); }
        if (!has_next) break;
#pragma unroll
        for (int a = 0; a < 2; ++a)
#pragma unroll
            for (int b = 0; b < 2; ++b)
#pragma unroll
                for (int m = 0; m < 4; ++m)
#pragma unroll
                    for (int n = 0; n < 2; ++n) acc[a][b][m][n] = (f32x4){0.f, 0.f, 0.f, 0.f};
        cur = nxt; cA = nA; cB = nB; ++ui;
        if constexpr (ALIGN_EPI) { if (wr == 1) PG8_BAR; }
    }
    PG8_WAIT_V(0);
    if constexpr (!ALIGN_EPI) { if (wr == 0) PG8_BAR; }
    PG8_BAR;
    if constexpr (Epi::AFTER_DRAIN) { E.fused(acc, cur, wr, wc, fr, fq, lds, wid, lane); S.done(cur); }
#undef PG8_SA
#undef PG8_SB
#undef PG8_STAGE
#undef PG8_LDA
#undef PG8_LDB
#undef PG8_MMA
#undef PG8_WAIT_V
#undef PG8_WAIT_L
#undef PG8_BAR
#undef PG8_SCHED
}
}

#ifndef MK_N_LAUNCHES
#define MK_N_LAUNCHES 1
#endif
constexpr int DM = 1024, MTOK = 32768, TOKP = 16384, DFF = 2816, NIN1 = 3072;
constexpr int NPH = 11;
constexpr float EPSN = 1e-6f;
constexpr size_t MiB = 1u << 20;
constexpr size_t WS_CTL = 0, WS_WIN = 1 * MiB, WS_WBA = 11 * MiB, WS_WBH = 12 * MiB, WS_WO = 13 * MiB, WS_WGU = 15 * MiB, WS_WD = 26 * MiB;
constexpr size_t WS_XB = 32 * MiB, WS_Q = 96 * MiB, WS_K = 128 * MiB, WS_VT = 160 * MiB, WS_FRP = 192 * MiB, WS_FRS = 200 * MiB;
constexpr size_t WS_M1 = 160 * MiB, WS_H = 96 * MiB, WS_END = 256 * MiB;
constexpr size_t OUT_HY = 0, OUT_UT = 96 * MiB, OUT_M2 = 0;
constexpr size_t CTL_SS0 = 0, CTL_SS1 = 128 * 1024, CTL_SS2 = 256 * 1024, CTL_F0 = 384 * 1024, CTL_CNT = 400 * 1024, CTL_BAR = 512 * 1024, CTL_BAR_BYTES = 16384;
constexpr int LDS_BYTES = 147456;

#define LAS __attribute__((address_space(3)))
typedef unsigned short bf16;
typedef unsigned u32x4 __attribute__((ext_vector_type(4)));
typedef unsigned u32x2 __attribute__((ext_vector_type(2)));
typedef float f32x4 __attribute__((ext_vector_type(4)));
typedef float f32x16 __attribute__((ext_vector_type(16)));
typedef short bf16x8 __attribute__((ext_vector_type(8)));
typedef float f32x2_t __attribute__((ext_vector_type(2)));
typedef __bf16 bf16x2_t __attribute__((ext_vector_type(2)));
#define DI __device__ __forceinline__
#define LDS_WAIT() asm volatile("s_waitcnt lgkmcnt(0)" ::: "memory")

DI unsigned pk2(float lo, float hi) { f32x2_t v = {lo, hi}; bf16x2_t b = __builtin_convertvector(v, bf16x2_t); return __builtin_bit_cast(unsigned, b); }
DI bf16 f2bf(float f) { return (bf16)(pk2(f, 0.f) & 0xffffu); }
DI float bf_lo(unsigned w) { return __uint_as_float(w << 16); }
DI float bf_hi(unsigned w) { return __uint_as_float(w & 0xffff0000u); }
DI float sigmoidf_(float x) { return 1.0f / (1.0f + __expf(-x)); }
DI float wave_sum(float v) {
#pragma unroll
    for (int o = 1; o < 64; o <<= 1) v += __shfl_xor(v, o);
    return v;
}
DI u32x4 ld16_l2(const void* p) {
    const unsigned long long* q = (const unsigned long long*)p;
    const unsigned long long a = __hip_atomic_load(q, __ATOMIC_RELAXED, __HIP_MEMORY_SCOPE_AGENT), b = __hip_atomic_load(q + 1, __ATOMIC_RELAXED, __HIP_MEMORY_SCOPE_AGENT);
    u32x4 r; r.x = (unsigned)a; r.y = (unsigned)(a >> 32); r.z = (unsigned)b; r.w = (unsigned)(b >> 32); return r;
}
DI int rot_t(int c, int t) { return (t + 128 * c) & (MTOK - 1); }
DI int crow(int reg, int h) { return (reg & 3) + 8 * (reg >> 2) + 4 * h; }

#ifdef PROBE_DUP
struct Args { const float* in[24]; float* out; unsigned char* ws; int ph_lo, ph_hi, dry, sub; };
#else
struct Args { const float* in[24]; float* out; unsigned char* ws; int ph_lo, ph_hi; };
#endif
struct Frame {
    LAS unsigned char* lds; int tid, lane, wave, G, bid;
    const float *xp, *xs;
};
DI const float* xrow(const Frame& F, int m) { return m < TOKP ? F.xp + (size_t)m * DM : F.xs + (size_t)(m - TOKP) * DM; }

using pg8::Unit; using pg8::BM; using pg8::HALF;
typedef const f32x4 (&AccRef)[2][2][4][2];
struct EpiIn {
    static constexpr bool PERM = true, AFTER_DRAIN = false;
    bf16 *Q, *K, *VT, *HY; const float* SS0;
    DI void operator()(AccRef acc, const Unit& u, int wr, int wc, int fr, int fq) const {
        const int row0 = u.pm * BM + wr * 64 + fr, cb = wc * 32 + 8 * fq, pn = u.pn;
#pragma unroll
        for (int ai = 0; ai < 2; ++ai)
#pragma unroll
            for (int m = 0; m < 4; ++m) {
                const int row = row0 + ai * HALF + m * 16;
                float rs = rsqrtf(SS0[row] * (1.0f / DM) + EPSN); if (pn < 2) rs *= 0.125f;
#pragma unroll
                for (int bj = 0; bj < 2; ++bj) {
                    const f32x4 v0 = acc[ai][bj][m][0] * rs, v1 = acc[ai][bj][m][1] * rs;
                    u32x4 w; w.x = pk2(v0[0], v0[1]); w.y = pk2(v0[2], v0[3]); w.z = pk2(v1[0], v1[1]); w.w = pk2(v1[2], v1[3]);
                    const int ct = bj * HALF + cb;
                    if (pn < 2)      *(u32x4*)(Q + (size_t)row * 512 + pn * 256 + ct) = w;
                    else if (pn < 4) *(u32x4*)(K + (size_t)row * 512 + (pn - 2) * 256 + ct) = w;
                    else if (pn < 6) { const int vc = (pn - 4) * 256 + ct; const unsigned wv[4] = {w.x, w.y, w.z, w.w};
_Pragma("unroll")
                        for (int e = 0; e < 8; ++e) VT[(size_t)(vc + e) * MTOK + rot_t(vc + e, row)] = (bf16)((e & 1) ? (wv[e >> 1] >> 16) : (wv[e >> 1] & 0xffffu)); }
                    else             *(u32x4*)(HY + (size_t)row * 1536 + (pn - 6) * 256 + ct) = w;
                }
            }
    }
};
struct EpiGate {
    static constexpr bool PERM = true, AFTER_DRAIN = false;
    bf16* D; const float* SS0;
    DI void operator()(AccRef acc, const Unit& u, int wr, int wc, int fr, int fq) const {
        const int row0 = u.pm * BM + wr * 64 + fr, col0 = u.pn * BM + wc * 32 + 8 * fq;
#pragma unroll
        for (int ai = 0; ai < 2; ++ai)
#pragma unroll
            for (int m = 0; m < 4; ++m) {
                const int row = row0 + ai * HALF + m * 16; const float rs = rsqrtf(SS0[row] * (1.0f / DM) + EPSN);
#pragma unroll
                for (int bj = 0; bj < 2; ++bj) {
                    const f32x4 v0 = acc[ai][bj][m][0] * rs, v1 = acc[ai][bj][m][1] * rs;
                    u32x4 w; w.x = pk2(sigmoidf_(v0[0]), sigmoidf_(v0[1])); w.y = pk2(sigmoidf_(v0[2]), sigmoidf_(v0[3])); w.z = pk2(sigmoidf_(v1[0]), sigmoidf_(v1[1])); w.w = pk2(sigmoidf_(v1[2]), sigmoidf_(v1[3]));
                    *(u32x4*)(D + (size_t)row * DM + col0 + bj * HALF) = w;
                }
            }
    }
};
template <int MODE> struct EpiMix {
    static constexpr bool PERM = true, AFTER_DRAIN = false;
    bf16* M1; const bf16* M2;
    DI void operator()(AccRef acc, const Unit& u, int wr, int wc, int fr, int fq) const {
        const int row0 = u.pm * BM + wr * 64 + fr, col0 = u.pn * BM + wc * 32 + 8 * fq;
#pragma unroll
        for (int ai = 0; ai < 2; ++ai)
#pragma unroll
            for (int m = 0; m < 4; ++m) {
                const int row = row0 + ai * HALF + m * 16;
#pragma unroll
                for (int bj = 0; bj < 2; ++bj) {
                    const size_t off = (size_t)row * DM + col0 + bj * HALF;
                    const f32x4 v0 = acc[ai][bj][m][0], v1 = acc[ai][bj][m][1];
                    const u32x4 a = ld16_l2(M1 + off); u32x4 w;
                    if (MODE == 0) {
                        w.x = pk2(bf_lo(a.x) * v0[0], bf_hi(a.x) * v0[1]); w.y = pk2(bf_lo(a.y) * v0[2], bf_hi(a.y) * v0[3]);
                        w.z = pk2(bf_lo(a.z) * v1[0], bf_hi(a.z) * v1[1]); w.w = pk2(bf_lo(a.w) * v1[2], bf_hi(a.w) * v1[3]);
                    } else {
                        const u32x4 b = ld16_l2(M2 + off);
                        w.x = pk2(bf_lo(a.x) + bf_lo(b.x) * v0[0], bf_hi(a.x) + bf_hi(b.x) * v0[1]); w.y = pk2(bf_lo(a.y) + bf_lo(b.y) * v0[2], bf_hi(a.y) + bf_hi(b.y) * v0[3]);
                        w.z = pk2(bf_lo(a.z) + bf_lo(b.z) * v1[0], bf_hi(a.z) + bf_hi(b.z) * v1[1]); w.w = pk2(bf_lo(a.w) + bf_lo(b.w) * v1[2], bf_hi(a.w) + bf_hi(b.w) * v1[3]);
                    }
                    *(u32x4*)(M1 + off) = w;
                }
            }
    }
};
template <bool FIRST, bool FUSE> struct EpiRes {
    static constexpr bool PERM = false, AFTER_DRAIN = false;
    const float *xp, *xs; float* out; bf16* XB; float* SS; int rowoff; bool dry; const float* gain; unsigned* cnt;
    DI f32x4 base4(int row, int col) const {
        if (FIRST) return *(const f32x4*)((row < TOKP ? xp + (size_t)row * DM : xs + (size_t)(row - TOKP) * DM) + col);
        const u32x2 w = *(const u32x2*)(XB + (size_t)row * DM + col); return (f32x4){bf_lo(w.x), bf_hi(w.x), bf_lo(w.y), bf_hi(w.y)};
    }
    DI void operator()(AccRef acc, const Unit& u, int wr, int wc, int fr, int fq) const {
        const int row0 = rowoff + u.pm * BM + wr * 64 + fr, col0 = u.pn * BM + wc * 32 + 4 * fq;
#pragma unroll
        for (int ai = 0; ai < 2; ++ai)
#pragma unroll
            for (int m = 0; m < 4; ++m) {
                const int row = row0 + ai * HALF + m * 16; float ss = 0.f;
#pragma unroll
                for (int bj = 0; bj < 2; ++bj)
#pragma unroll
                    for (int n = 0; n < 2; ++n) {
                        const int col = col0 + bj * HALF + n * 16;
                        const f32x4 x = base4(row, col) + acc[ai][bj][m][n];
                        ss += (x[0] * x[0] + x[1] * x[1]) + (x[2] * x[2] + x[3] * x[3]);
                        if (FIRST && !dry) { u32x2 w; w.x = pk2(x[0], x[1]); w.y = pk2(x[2], x[3]); *(u32x2*)(XB + (size_t)row * DM + col) = w; }
                    }
                ss += __shfl_xor(ss, 16); ss += __shfl_xor(ss, 32);
                if (fq == 0 && !dry) unsafeAtomicAdd(SS + row, ss);
            }
        if (FUSE) {
            unsigned* pc = cnt + 16 * ((rowoff >> 8) + u.pm);
            asm volatile("s_waitcnt vmcnt(0)" ::: "memory");
            if ((threadIdx.x & 63) == 0) __hip_atomic_fetch_add(pc, 1u, __ATOMIC_RELAXED, __HIP_MEMORY_SCOPE_AGENT);
            unsigned spins = 0;
            for (;;) { const unsigned v = __hip_atomic_load(pc, __ATOMIC_RELAXED, __HIP_MEMORY_SCOPE_AGENT);
                if ((unsigned)__builtin_amdgcn_readfirstlane(v) >= 32u || ++spins > (1u << 22)) break; __builtin_amdgcn_s_sleep(2); }
            __builtin_amdgcn_fence(__ATOMIC_ACQUIRE, "agent");
#pragma unroll
            for (int ai = 0; ai < 2; ++ai)
#pragma unroll
                for (int m = 0; m < 4; ++m) {
                    const int row = row0 + ai * HALF + m * 16;
                    const float rs = rsqrtf(__hip_atomic_load(SS + row, __ATOMIC_RELAXED, __HIP_MEMORY_SCOPE_AGENT) * (1.0f / DM) + EPSN);
#pragma unroll
                    for (int bj = 0; bj < 2; ++bj)
#pragma unroll
                        for (int n = 0; n < 2; ++n) {
                            const int col = col0 + bj * HALF + n * 16;
                            const f32x4 x = base4(row, col) + acc[ai][bj][m][n];
                            if (!dry) *(f32x4*)(out + (size_t)row * DM + col) = x * rs * *(const f32x4*)(gain + col);
                        }
                }
        }
    }
};
struct EpiSwiglu {
    static constexpr bool PERM = true, AFTER_DRAIN = false;
    bf16* H; const float* SS1;
    DI void operator()(AccRef acc, const Unit& u, int wr, int wc, int fr, int fq) const {
        const int row0 = u.pm * BM + wr * 64 + fr, col0 = u.pn * 128 + wc * 32 + 8 * fq;
#pragma unroll
        for (int ai = 0; ai < 2; ++ai)
#pragma unroll
            for (int m = 0; m < 4; ++m) {
                const int row = row0 + ai * HALF + m * 16; const float rs = rsqrtf(SS1[row] * (1.0f / DM) + EPSN);
                float h[8];
#pragma unroll
                for (int n = 0; n < 2; ++n)
#pragma unroll
                    for (int e = 0; e < 4; ++e) { const float g = acc[ai][0][m][n][e] * rs, up = acc[ai][1][m][n][e] * rs; h[4 * n + e] = g * sigmoidf_(g) * up; }
                u32x4 w; w.x = pk2(h[0], h[1]); w.y = pk2(h[2], h[3]); w.z = pk2(h[4], h[5]); w.w = pk2(h[6], h[7]);
                *(u32x4*)(H + (size_t)row * DFF + col0) = w;
            }
    }
};

DI void p0_transpose_item(const float* W, int K, int N, bf16* WT, const float* gk, int gumode, LAS float* scr, int item, int lane) {
    const int nblk = N / 32, kb = item / nblk, nb = item % nblk, k0 = 64 * kb, n0 = 32 * nb;
    const int drow0 = gumode == 0 ? n0 : ((n0 >> 7) * 256 + (n0 & 127) + (gumode == 2 ? 128 : 0));
#pragma unroll 16
    for (int i = 0; i < 32; ++i) { const int kk = 2 * i + (lane >> 5); float v = W[(size_t)(k0 + kk) * N + n0 + (lane & 31)]; if (gk) v *= gk[k0 + kk]; scr[kk * 33 + (lane & 31)] = v; }
    LDS_WAIT(); asm volatile("" ::: "memory");
    const int c = lane & 7;
#pragma unroll
    for (int j = 0; j < 4; ++j) { const int n = (lane >> 3) + 8 * j; const LAS float* s = scr + (8 * c) * 33 + n;
        u32x4 o; o.x = pk2(s[0 * 33], s[1 * 33]); o.y = pk2(s[2 * 33], s[3 * 33]); o.z = pk2(s[4 * 33], s[5 * 33]); o.w = pk2(s[6 * 33], s[7 * 33]);
        *(u32x4*)(WT + (size_t)(drow0 + n) * K + k0 + 8 * c) = o; }
    LDS_WAIT(); asm volatile("" ::: "memory");
}
DI float sin_rad(float x) { return __builtin_amdgcn_sinf(x * 0.15915494309189535f); }
constexpr int FLT_WL = 51200;
DI void filter_stage_weights(const Frame& F, const float* w1, const float* b1, const float* w2, const float* b2, const float* w3, const float* b3, const float* freq) {
    LAS float* wl = (LAS float*)(F.lds + FLT_WL);
    for (int i = F.tid; i < 2112; i += 512) wl[i] = w1[i];
    for (int i = F.tid; i < 4096; i += 512) { wl[2112 + i] = w2[i]; wl[6208 + i] = w3[i]; }
    if (F.tid < 64) { wl[10304 + F.tid] = b1[F.tid]; wl[10368 + F.tid] = b2[F.tid]; wl[10432 + F.tid] = b3[F.tid]; wl[10496 + F.tid] = freq[F.tid]; }
    __syncthreads();
}
DI void filter_unit(const Frame& F, int L, int p0, bf16* FR, float* F0, const float* w4) {
    const LAS float* w1 = (const LAS float*)(F.lds + FLT_WL); const LAS float* w2 = w1 + 2112; const LAS float* w3 = w1 + 6208;
    const LAS float* b1 = w1 + 10304; const LAS float* b2 = w1 + 10368; const LAS float* b3 = w1 + 10432; const LAS float* freq = w1 + 10496;
    LAS float* zs = (LAS float*)F.lds;
    LAS float* hA = (LAS float*)(F.lds + 8448);
    LAS float* hB = (LAS float*)(F.lds + 8448 + 16384);
    LAS unsigned char* H3 = F.lds + 8448 + 32768;
    const int p = F.lane, g = F.wave, pos = p0 + p;
    {
        if (g == 0) zs[p] = (float)pos / (float)(L - 1);
#pragma unroll
        for (int ii = 0; ii < 2; ++ii) { const int i = 2 * g + ii; const float fb = 1e-4f + (float)i * ((15.0f - 1e-4f) / 15.0f);
            float x = (float)pos * fb / (float)L; x = x - floorf(x);
            zs[(1 + i) * 64 + p] = __builtin_amdgcn_cosf(x); zs[(17 + i) * 64 + p] = -__builtin_amdgcn_sinf(x); }
    }
    __syncthreads();
    float fq8[8];
#pragma unroll
    for (int j = 0; j < 8; ++j) fq8[j] = freq[8 * g + j];
    {
        float a[8];
#pragma unroll
        for (int j = 0; j < 8; ++j) a[j] = b1[8 * g + j];
#pragma unroll 11
        for (int k = 0; k < 33; ++k) { const float z = zs[k * 64 + p]; const f32x4 wa = *(const LAS f32x4*)(w1 + k * 64 + 8 * g), wb = *(const LAS f32x4*)(w1 + k * 64 + 8 * g + 4);
            a[0] += z * wa[0]; a[1] += z * wa[1]; a[2] += z * wa[2]; a[3] += z * wa[3]; a[4] += z * wb[0]; a[5] += z * wb[1]; a[6] += z * wb[2]; a[7] += z * wb[3]; }
#pragma unroll
        for (int j = 0; j < 8; ++j) hA[(8 * g + j) * 64 + p] = sin_rad(fq8[j] * a[j]);
    }
    __syncthreads();
    {
        float a[8];
#pragma unroll
        for (int j = 0; j < 8; ++j) a[j] = b2[8 * g + j];
#pragma unroll 8
        for (int k = 0; k < 64; ++k) { const float z = hA[k * 64 + p]; const f32x4 wa = *(const LAS f32x4*)(w2 + k * 64 + 8 * g), wb = *(const LAS f32x4*)(w2 + k * 64 + 8 * g + 4);
            a[0] += z * wa[0]; a[1] += z * wa[1]; a[2] += z * wa[2]; a[3] += z * wa[3]; a[4] += z * wb[0]; a[5] += z * wb[1]; a[6] += z * wb[2]; a[7] += z * wb[3]; }
#pragma unroll
        for (int j = 0; j < 8; ++j) hB[(8 * g + j) * 64 + p] = sin_rad(fq8[j] * a[j]);
    }
    __syncthreads();
    {
        float a[8];
#pragma unroll
        for (int j = 0; j < 8; ++j) a[j] = b3[8 * g + j];
#pragma unroll 8
        for (int k = 0; k < 64; ++k) { const float z = hB[k * 64 + p]; const f32x4 wa = *(const LAS f32x4*)(w3 + k * 64 + 8 * g), wb = *(const LAS f32x4*)(w3 + k * 64 + 8 * g + 4);
            a[0] += z * wa[0]; a[1] += z * wa[1]; a[2] += z * wa[2]; a[3] += z * wa[3]; a[4] += z * wb[0]; a[5] += z * wb[1]; a[6] += z * wb[2]; a[7] += z * wb[3]; }
        u32x4 w; w.x = pk2(sin_rad(fq8[0] * a[0]), sin_rad(fq8[1] * a[1])); w.y = pk2(sin_rad(fq8[2] * a[2]), sin_rad(fq8[3] * a[3]));
        w.z = pk2(sin_rad(fq8[4] * a[4]), sin_rad(fq8[5] * a[5])); w.w = pk2(sin_rad(fq8[6] * a[6]), sin_rad(fq8[7] * a[7]));
        *(LAS u32x4*)(H3 + p * 144 + 16 * g) = w;
    }
    __syncthreads();
    const int r32 = F.lane & 31, hh = F.lane >> 5;
    bf16x8 bfr[2][4];
#pragma unroll
    for (int pt = 0; pt < 2; ++pt)
#pragma unroll
        for (int s = 0; s < 4; ++s) bfr[pt][s] = *(const LAS bf16x8*)(H3 + (32 * pt + r32) * 144 + (16 * s + 8 * hh) * 2);
    const float mind = -3.0701134573253945f, maxd = -15.350567286626972f;
    const int dir = g >> 2;
    for (int cti = 0; cti < 4; ++cti) {
        const int ct = 4 * g + cti;
        f32x16 acc0, acc1;
#pragma unroll
        for (int i = 0; i < 16; ++i) { acc0[i] = 0.f; acc1[i] = 0.f; }
#pragma unroll
        for (int s = 0; s < 4; ++s) {
            const float* wp = w4 + (size_t)(16 * s + 8 * hh) * 1024 + 32 * ct + r32;
            u32x4 aw; aw.x = pk2(wp[0], wp[1024]); aw.y = pk2(wp[2048], wp[3072]); aw.z = pk2(wp[4096], wp[5120]); aw.w = pk2(wp[6144], wp[7168]);
            const bf16x8 af = __builtin_bit_cast(bf16x8, aw);
            acc0 = __builtin_amdgcn_mfma_f32_32x32x16_bf16(af, bfr[0][s], acc0, 0, 0, 0);
            acc1 = __builtin_amdgcn_mfma_f32_32x32x16_bf16(af, bfr[1][s], acc1, 0, 0, 0);
        }
#pragma unroll
        for (int pt = 0; pt < 2; ++pt) {
            const int ps = p0 + 32 * pt + r32; const float tpos = (float)ps / (float)(L - 1);
#pragma unroll
            for (int i = 0; i < 16; ++i) {
                const int c = (32 * ct + crow(i, hh)) & 511;
                const float delta = fabsf(mind + (float)c * ((maxd - mind) / 511.0f));
                const float val = (pt == 0 ? acc0[i] : acc1[i]) * __expf(-tpos * delta);
                bf16* row = FR + (size_t)c * 2 * L;
                if (ps == 0) { F0[dir * 512 + c] = val; if (dir == 0) row[0] = 0; }
                else row[dir ? L + ps : L - ps] = f2bf(val);
            }
        }
    }
    __syncthreads();
}

DI void conv3_load(const bf16* HY, int tok, int col, bool hp, bool hn, u32x4& a, u32x4& b, u32x4& c) {
    const u32x4 z = {0u, 0u, 0u, 0u};
    const bf16* p = HY + (size_t)tok * 1536 + col;
    b = *(const u32x4*)p; a = hp ? *(const u32x4*)(p - 1536) : z; c = hn ? *(const u32x4*)(p + 1536) : z;
}
DI void conv3_apply(const u32x4& a, const u32x4& b, const u32x4& c, const float* cw, const float* cb, int col, float* o) {
    float w0[8], w1[8], w2[8], bb[8];
    *(f32x4*)(w0) = *(const f32x4*)(cw + col); *(f32x4*)(w0 + 4) = *(const f32x4*)(cw + col + 4);
    *(f32x4*)(w1) = *(const f32x4*)(cw + 1536 + col); *(f32x4*)(w1 + 4) = *(const f32x4*)(cw + 1536 + col + 4);
    *(f32x4*)(w2) = *(const f32x4*)(cw + 3072 + col); *(f32x4*)(w2 + 4) = *(const f32x4*)(cw + 3072 + col + 4);
    *(f32x4*)(bb) = *(const f32x4*)(cb + col); *(f32x4*)(bb + 4) = *(const f32x4*)(cb + col + 4);
#pragma unroll
    for (int d = 0; d < 4; ++d) {
        o[2 * d]     = w0[2 * d] * bf_lo(a[d]) + w1[2 * d] * bf_lo(b[d]) + w2[2 * d] * bf_lo(c[d]) + bb[2 * d];
        o[2 * d + 1] = w0[2 * d + 1] * bf_hi(a[d]) + w1[2 * d + 1] * bf_hi(b[d]) + w2[2 * d + 1] * bf_hi(c[d]) + bb[2 * d + 1];
    }
}
DI void tok_edges(int tok, bool& hp, bool& hn) {
    const int tp = tok < TOKP ? (tok & 4095) : tok - TOKP, Ls = tok < TOKP ? 4096 : 16384;
    hp = tp > 0; hn = tp < Ls - 1;
}
struct ConvW { float w0[8], w1[8], w2[8], bb[8]; };
DI void conv3_w(ConvW& W, const float* cw, const float* cb, int col) {
    *(f32x4*)(W.w0) = *(const f32x4*)(cw + col); *(f32x4*)(W.w0 + 4) = *(const f32x4*)(cw + col + 4);
    *(f32x4*)(W.w1) = *(const f32x4*)(cw + 1536 + col); *(f32x4*)(W.w1 + 4) = *(const f32x4*)(cw + 1536 + col + 4);
    *(f32x4*)(W.w2) = *(const f32x4*)(cw + 3072 + col); *(f32x4*)(W.w2 + 4) = *(const f32x4*)(cw + 3072 + col + 4);
    *(f32x4*)(W.bb) = *(const f32x4*)(cb + col); *(f32x4*)(W.bb + 4) = *(const f32x4*)(cb + col + 4);
}
DI void conv3_do(const ConvW& W, const u32x4& a, const u32x4& b, const u32x4& c, float* o) {
#pragma unroll
    for (int d = 0; d < 4; ++d) {
        o[2 * d]     = W.w0[2 * d] * bf_lo(a[d]) + W.w1[2 * d] * bf_lo(b[d]) + W.w2[2 * d] * bf_lo(c[d]) + W.bb[2 * d];
        o[2 * d + 1] = W.w0[2 * d + 1] * bf_hi(a[d]) + W.w1[2 * d + 1] * bf_hi(b[d]) + W.w2[2 * d + 1] * bf_hi(c[d]) + W.bb[2 * d + 1];
    }
}
constexpr int TR_ROW = 272;
DI void p2b_unit(const Frame& F, int unit, const bf16* HY, bf16* UT, const float* cw, const float* cb) {
    const int tt = unit >> 3, cgp = unit & 7;
    LAS unsigned char* T = F.lds;
    { const int t0 = F.tid >> 3, cc = (F.tid & 7) * 8, c0 = cgp * 64 + cc;
      u32x4 xa[2], xb[2], xc[2], va[2], vb[2], vc[2];
#pragma unroll
      for (int j = 0; j < 2; ++j) { const int tok = tt * 128 + t0 + 64 * j; bool hp, hn; tok_edges(tok, hp, hn);
          conv3_load(HY, tok, 512 + c0, hp, hn, xa[j], xb[j], xc[j]); conv3_load(HY, tok, 1024 + c0, hp, hn, va[j], vb[j], vc[j]); }
      ConvW W1, WV; conv3_w(W1, cw, cb, 512 + c0); conv3_w(WV, cw, cb, 1024 + c0);
#pragma unroll
      for (int j = 0; j < 2; ++j) { float x1[8], hv[8]; conv3_do(W1, xa[j], xb[j], xc[j], x1); conv3_do(WV, va[j], vb[j], vc[j], hv);
#pragma unroll
          for (int e = 0; e < 8; ++e) *(LAS bf16*)(T + (cc + e) * TR_ROW + (t0 + 64 * j) * 2) = f2bf(x1[e] * hv[e]); } }
    __syncthreads();
    { const int c = F.tid >> 3, cg = cgp * 64 + c;
#pragma unroll
      for (int j = 0; j < 2; ++j) { const int tch = (F.tid & 7) * 8 + 64 * j;
          *(u32x4*)(UT + (size_t)cg * MTOK + rot_t(cg, tt * 128 + tch)) = *(const LAS u32x4*)(T + c * TR_ROW + tch * 2); } }
    __syncthreads();
}
DI void p2d_unit(const Frame& F, int unit, const bf16* HY, const bf16* YT, bf16* YH, const float* cw, const float* cb) {
    const int tt = unit >> 3, cgp = unit & 7;
    LAS unsigned char* T = F.lds;
    const int t0 = F.tid >> 3, cc = (F.tid & 7) * 8, c0 = cgp * 64 + cc;
    u32x4 xa[2], xb[2], xc[2];
#pragma unroll
    for (int j = 0; j < 2; ++j) { const int tok = tt * 128 + t0 + 64 * j; bool hp, hn; tok_edges(tok, hp, hn); conv3_load(HY, tok, c0, hp, hn, xa[j], xb[j], xc[j]); }
    { const int c = F.tid >> 3, cg = cgp * 64 + c;
#pragma unroll
      for (int j = 0; j < 2; ++j) { const int tch = (F.tid & 7) * 8 + 64 * j;
          *(LAS u32x4*)(T + c * TR_ROW + tch * 2) = *(const u32x4*)(YT + (size_t)cg * MTOK + rot_t(cg, tt * 128 + tch)); } }
    __syncthreads();
    { ConvW W0; conv3_w(W0, cw, cb, c0);
#pragma unroll
      for (int j = 0; j < 2; ++j) { const int t = t0 + 64 * j, tok = tt * 128 + t; float x0[8], y[8]; conv3_do(W0, xa[j], xb[j], xc[j], x0);
#pragma unroll
          for (int e = 0; e < 8; ++e) y[e] = __uint_as_float((unsigned)(*(const LAS bf16*)(T + (cc + e) * TR_ROW + t * 2)) << 16) * x0[e];
          u32x4 w; w.x = pk2(y[0], y[1]); w.y = pk2(y[2], y[3]); w.z = pk2(y[4], y[5]); w.w = pk2(y[6], y[7]);
          *(u32x4*)(YH + (size_t)tok * 512 + c0) = w; } }
    __syncthreads();
}

DI u32x4 shift8(const u32x4 lo, const u32x4 hi, int e) {
    u32x4 r;
    const int ds = e >> 1;
    unsigned w0, w1, w2, w3, w4;
    if (ds == 0) { w0 = lo.x; w1 = lo.y; w2 = lo.z; w3 = lo.w; w4 = hi.x; }
    else if (ds == 1) { w0 = lo.y; w1 = lo.z; w2 = lo.w; w3 = hi.x; w4 = hi.y; }
    else if (ds == 2) { w0 = lo.z; w1 = lo.w; w2 = hi.x; w3 = hi.y; w4 = hi.z; }
    else { w0 = lo.w; w1 = hi.x; w2 = hi.y; w3 = hi.z; w4 = hi.w; }
    if (e & 1) { r.x = __builtin_amdgcn_alignbit(w1, w0, 16); r.y = __builtin_amdgcn_alignbit(w2, w1, 16); r.z = __builtin_amdgcn_alignbit(w3, w2, 16); r.w = __builtin_amdgcn_alignbit(w4, w3, 16); }
    else { r.x = w0; r.y = w1; r.z = w2; r.w = w3; }
    return r;
}
constexpr int CONV_FR_MAX = 2 * 16384 * 2 + 16 * 64;
template <int L, int NB>
DI void conv_unit(const Frame& F, int c, const bf16* FRg, const float* F0, const float* hyD, const bf16* UT, bf16* YT, int tok0, bool dry) {
    constexpr int RS = L / 32, LOGRS = (RS == 512 ? 9 : 7), JB = 32 / NB, WN = (NB == 1 ? 2560 : 640), WCH = WN / 8, WSTEPS = (NB == 1 ? 120 : 24), BST = (NB == 1 ? 5120 : 1408)  ;
    constexpr int NSTEPS = (L + RS) / 16, NWIN = (NSTEPS + WSTEPS - 1) / WSTEPS;
    static_assert(NB * WCH == 320 && WSTEPS % 6 == 0 && (NSTEPS % WSTEPS) % 6 == 0, "window chunks / steps");
    LAS unsigned char* fr = F.lds; LAS unsigned char* uw = F.lds + CONV_FR_MAX + F.wave * 5632;
    const int lane = F.lane, wave = F.wave, r32 = lane & 31, hh = lane >> 5;
    const bf16* ubase = UT + (size_t)c * MTOK;
    const u32x4 z4 = {0u, 0u, 0u, 0u};
    u32x4 lo[5], hi[5];
#define CONV_ISSUE(win) do { const int d0_ = -RS + (win) * WSTEPS * 16; _Pragma("unroll") for (int r_ = 0; r_ < 5; ++r_) { const int cid_ = lane + 64 * r_, b_ = cid_ / WCH, q_ = cid_ % WCH; \
        const int s_ = d0_ + 8 * q_; const int g_ = tok0 + b_ * L + s_; lo[r_] = (s_ >= 0 && s_ < L) ? *(const u32x4*)(ubase + rot_t(c, g_)) : z4; hi[r_] = (s_ + 8 >= 0 && s_ + 8 < L) ? *(const u32x4*)(ubase + rot_t(c, g_ + 8)) : z4; } } while (0)
    CONV_ISSUE(0);
    {
        const bf16* frow = FRg + (size_t)c * 2 * L;
        for (int ch = F.tid; ch < 2 * L / 8; ch += 512) { const u32x4 v = *(const u32x4*)(frow + 8 * ch); const int x0 = 8 * ch; *(LAS u32x4*)(fr + 2 * x0 + ((x0 >> LOGRS) << 4)) = v; }
        __syncthreads();
        if (F.tid == 0) *(LAS bf16*)(fr + 2 * L + ((L >> LOGRS) << 4)) = f2bf(F0[c] + F0[512 + c] + hyD[c]);
        __syncthreads();
    }
    f32x16 acc0, acc1;
#pragma unroll
    for (int i = 0; i < 16; ++i) { acc0[i] = 0.f; acc1[i] = 0.f; }
    const int jj = r32 % JB, bb = r32 / JB;
    const int xA0 = L - RS * r32 + 8 * hh - RS;
    const LAS unsigned char* ubp0 = uw + bb * BST + hh * WN + 16 * jj;
    const LAS unsigned char* ubp1 = uw + bb * BST + (1 - hh) * WN + 16 * (jj + hh);
    for (int win = 0; win < NWIN; ++win) {
        asm volatile("" ::: "memory");
#pragma unroll
        for (int r = 0; r < 5; ++r) { const int cid = lane + 64 * r, b = cid / WCH, q = cid % WCH;
            *(LAS u32x4*)(uw + b * BST + (q & 1) * WN + 16 * (q >> 1)) = shift8(lo[r], hi[r], wave); }
        LDS_WAIT();
        if (win + 1 < NWIN) CONV_ISSUE(win + 1);
        int nst = (NSTEPS - win * WSTEPS) < WSTEPS ? (NSTEPS - win * WSTEPS) : WSTEPS;
#ifdef PROBE_CONV_NOLOOP
        if (dry) nst = 4;
#endif
        const int xw = xA0 + win * WSTEPS * 16;
#define CONV_LD(A_, B0_, B1_, m_) do { const int xA_ = xw + 16 * (m_); A_ = *(const LAS bf16x8*)(fr + 2 * xA_ + ((xA_ >> LOGRS) << 4)); \
            B0_ = *(const LAS bf16x8*)(ubp0 + 16 * (m_)); B1_ = *(const LAS bf16x8*)(ubp1 + 16 * (m_)); } while (0)
#ifdef CONV_SIMPLE
        for (int m = 0; m < nst; ++m) { bf16x8 a_, b0_, b1_; CONV_LD(a_, b0_, b1_, m);
            acc0 = __builtin_amdgcn_mfma_f32_32x32x16_bf16(a_, b0_, acc0, 0, 0, 0);
            acc1 = __builtin_amdgcn_mfma_f32_32x32x16_bf16(a_, b1_, acc1, 0, 0, 0); }
#else
#define CONV_KEEP(k_) asm volatile("" :: "v"(fa[k_][0]), "v"(fb0[k_][0]), "v"(fb1[k_][0]), "v"(fa[k_][1]), "v"(fb0[k_][1]), "v"(fb1[k_][1]))
#define CONV_MM(k_) do { acc0 = __builtin_amdgcn_mfma_f32_32x32x16_bf16(fa[k_][0], fb0[k_][0], acc0, 0, 0, 0); acc1 = __builtin_amdgcn_mfma_f32_32x32x16_bf16(fa[k_][0], fb1[k_][0], acc1, 0, 0, 0); \
                         acc0 = __builtin_amdgcn_mfma_f32_32x32x16_bf16(fa[k_][1], fb0[k_][1], acc0, 0, 0, 0); acc1 = __builtin_amdgcn_mfma_f32_32x32x16_bf16(fa[k_][1], fb1[k_][1], acc1, 0, 0, 0); } while (0)
#define CONV_GLD(k_, g_) do { const int xg_ = xw + 32 * (g_); const LAS unsigned char* pa_ = fr + 2 * xg_ + ((xg_ >> LOGRS) << 4); \
            fa[k_][0] = *(const LAS bf16x8*)pa_; fa[k_][1] = *(const LAS bf16x8*)(pa_ + 32); \
            fb0[k_][0] = *(const LAS bf16x8*)(ubp0 + 32 * (g_)); fb0[k_][1] = *(const LAS bf16x8*)(ubp0 + 32 * (g_) + 16); \
            fb1[k_][0] = *(const LAS bf16x8*)(ubp1 + 32 * (g_)); fb1[k_][1] = *(const LAS bf16x8*)(ubp1 + 32 * (g_) + 16); } while (0)
        bf16x8 fa[3][2], fb0[3][2], fb1[3][2];
        fa[2][0] = (bf16x8){0, 0, 0, 0, 0, 0, 0, 0}; fa[2][1] = fa[2][0]; fb0[2][0] = fa[2][0]; fb0[2][1] = fa[2][0]; fb1[2][0] = fa[2][0]; fb1[2][1] = fa[2][0];
        CONV_GLD(0, 0); CONV_GLD(1, 1);
        const int ng = nst >> 1;
        int g = 0;
        for (; g + 3 < ng; g += 3) {
            CONV_MM(0); CONV_KEEP(2); CONV_GLD(2, g + 2);
            CONV_MM(1); CONV_KEEP(0); CONV_GLD(0, g + 3);
            CONV_MM(2); CONV_KEEP(1); CONV_GLD(1, g + 4);
        }
        CONV_MM(0); CONV_KEEP(2); CONV_GLD(2, g + 2);
        CONV_MM(1); CONV_KEEP(0);
        CONV_MM(2); CONV_KEEP(1);
        CONV_KEEP(2);
#undef CONV_KEEP
#undef CONV_MM
#undef CONV_GLD
#endif
#undef CONV_LD
        LDS_WAIT();
    }
#undef CONV_ISSUE
    __syncthreads();
    LAS bf16* ys = (LAS bf16*)F.lds;
#pragma unroll
    for (int i = 0; i < 16; ++i) { const int t = RS * crow(i, hh) + 16 * jj + wave;
        ys[bb * L + t] = f2bf(acc0[i]); ys[bb * L + t + 8] = f2bf(acc1[i]); }
    __syncthreads();
    if (!dry) for (int ch = F.tid; ch < NB * L / 8; ch += 512) *(u32x4*)(YT + (size_t)c * MTOK + rot_t(c, tok0 + 8 * ch)) = *(const LAS u32x4*)(ys + 8 * ch);
    __syncthreads();
}

constexpr int ATT_KROW = 144, ATT_VROW = 80, ATT_KBYTES = 32 * ATT_KROW, ATT_WAVE_LDS = ATT_KBYTES + 64 * ATT_VROW;
struct AttnRegs { u32x4 k[4], v[4]; };
DI void attn_gload(AttnRegs& R, const bf16* Kb, const bf16* VT, int h, int tokk, int qh, int t, int lane) {
    const int ecol0 = qh ? 24 : 32;
    int ktok, vtok, kstep;
    if (t < 8) { ktok = tokk + 64 * t + 32 * qh + (lane >> 3); kstep = 8; vtok = tokk + 64 * t + 32 * qh + 8 * (lane & 3); }
    else { ktok = tokk + 256 * (t - 8) + ecol0 + (lane >> 3); kstep = 64; vtok = tokk + 256 * (t - 8) + 64 * (lane & 3) + ecol0; }
    const bf16* kp = Kb + (size_t)ktok * 512 + h * 64 + (lane & 7) * 8;
#pragma unroll
    for (int j = 0; j < 4; ++j) R.k[j] = *(const u32x4*)(kp + (size_t)j * kstep * 512);
#pragma unroll
    for (int j = 0; j < 4; ++j) { const int vc = h * 64 + (lane >> 2) + 16 * j; R.v[j] = *(const u32x4*)(VT + (size_t)vc * MTOK + rot_t(vc, vtok)); }
}
DI void attn_stage(const AttnRegs& R, LAS unsigned char* wl, int lane) {
#pragma unroll
    for (int j = 0; j < 4; ++j) *(LAS u32x4*)(wl + ((lane >> 3) + 8 * j) * ATT_KROW + (lane & 7) * 16) = R.k[j];
#pragma unroll
    for (int j = 0; j < 4; ++j) *(LAS u32x4*)(wl + ATT_KBYTES + ((lane >> 2) + 16 * j) * ATT_VROW + (lane & 3) * 16) = R.v[j];
}
struct AttnState { float mrun, lrun; f32x16 o0, o1; };
template <bool COMB> DI void attn_tile(AttnState& st, const LAS unsigned char* wl, const bf16x8 (&qf)[4], const LAS float* tab, int tb, int d0, int r32, int hh) {
    f32x16 S;
#pragma unroll
    for (int i = 0; i < 16; ++i) S[i] = 0.f;
#pragma unroll
    for (int ks = 0; ks < 4; ++ks) { const bf16x8 kf = *(const LAS bf16x8*)(wl + r32 * ATT_KROW + 32 * ks + 16 * hh); S = __builtin_amdgcn_mfma_f32_32x32x16_bf16(kf, qf[ks], S, 0, 0, 0); }
    u32x2 va[2][2][2];
#pragma unroll
    for (int dt = 0; dt < 2; ++dt)
#pragma unroll
        for (int s = 0; s < 2; ++s) { const LAS unsigned char* vp = wl + ATT_KBYTES + (32 * dt + r32) * ATT_VROW + 32 * s + 8 * hh; va[dt][s][0] = *(const LAS u32x2*)vp; va[dt][s][1] = *(const LAS u32x2*)(vp + 16); }
    float sv[16]; float mx = -1e30f;
    const LAS float* tp = tab + 48 + tb;
    float bias[16];
#pragma unroll
    for (int i = 0; i < 16; ++i) bias[i] = tp[COMB ? (i & 3) + 31 * (i >> 2) : (i & 3) + 8 * (i >> 2)];
#pragma unroll
    for (int i = 0; i < 16; ++i) { const int ko = COMB ? (i & 3) : (i & 3) + 8 * (i >> 2); const bool valid = (unsigned)(d0 + ko) < 16u;
        sv[i] = valid ? S[i] + bias[i] : -1e30f; mx = fmaxf(mx, sv[i]); }
    mx = fmaxf(mx, __shfl_xor(mx, 32));
    const float mnew = fmaxf(st.mrun, mx);
    if (__builtin_amdgcn_ballot_w64(mnew > st.mrun) != 0ull) {
        const float scale = __expf(st.mrun - mnew); st.mrun = mnew; st.lrun *= scale;
#pragma unroll
        for (int i = 0; i < 16; ++i) { st.o0[i] *= scale; st.o1[i] *= scale; }
    }
    float ps = 0.f;
#pragma unroll
    for (int i = 0; i < 16; ++i) { const float p = __expf(sv[i] - mnew); sv[i] = p; ps += p; }
    st.lrun += ps;
#pragma unroll
    for (int s = 0; s < 2; ++s) {
        u32x4 pw; pw.x = pk2(sv[8 * s], sv[8 * s + 1]); pw.y = pk2(sv[8 * s + 2], sv[8 * s + 3]); pw.z = pk2(sv[8 * s + 4], sv[8 * s + 5]); pw.w = pk2(sv[8 * s + 6], sv[8 * s + 7]);
        const bf16x8 pb = __builtin_bit_cast(bf16x8, pw);
        u32x4 a0; a0.x = va[0][s][0].x; a0.y = va[0][s][0].y; a0.z = va[0][s][1].x; a0.w = va[0][s][1].y;
        u32x4 a1; a1.x = va[1][s][0].x; a1.y = va[1][s][0].y; a1.z = va[1][s][1].x; a1.w = va[1][s][1].y;
        st.o0 = __builtin_amdgcn_mfma_f32_32x32x16_bf16(__builtin_bit_cast(bf16x8, a0), pb, st.o0, 0, 0, 0);
        st.o1 = __builtin_amdgcn_mfma_f32_32x32x16_bf16(__builtin_bit_cast(bf16x8, a1), pb, st.o1, 0, 0, 0);
    }
}
DI void attn_unit(int grow, int h, int qh, const bf16* Qb, const bf16* Kb, const bf16* VT, bf16* O, const float* rpb, LAS float* tab, LAS unsigned char* wl, int lane, int& cur_head, bool dry) {
    const int r32 = lane & 31, hh = lane >> 5;
    const int g0 = grow < 256 ? (grow & ~63) : 256, rows = grow < 256 ? 64 : 256, r = grow - g0;
    int rs = r - 4; rs = rs < 0 ? 0 : (rs > rows - 8 ? rows - 8 : rs);
    if (cur_head != h) { for (int i = lane; i < 465; i += 64) tab[48 + i] = rpb[h * 465 + i]; cur_head = h; LDS_WAIT(); }
    const int tokq = grow * 64 + 32 * qh + r32;
    const int tokk = (g0 + rs) * 64;
    AttnRegs R;
    attn_gload(R, Kb, VT, h, tokk, qh, 0, lane);
    bf16x8 qf[4];
#pragma unroll
    for (int ks = 0; ks < 4; ++ks) qf[ks] = *(const bf16x8*)(Qb + (size_t)tokq * 512 + h * 64 + 16 * ks + 8 * hh);
    const int c = 32 * qh + r32; int cs = c - 8; cs = cs < 0 ? 0 : (cs > 48 ? 48 : cs);
    asm volatile("" : "+v"(qf[0]), "+v"(qf[1]), "+v"(qf[2]), "+v"(qf[3]));
    AttnState st; st.mrun = -1e20f; st.lrun = 0.f;
#pragma unroll
    for (int i = 0; i < 16; ++i) { st.o0[i] = 0.f; st.o1[i] = 0.f; }
    const int ecol0 = qh ? 24 : 32;
    const int tb0 = (rs - r + 7) * 31 + 15 - c + 4 * hh;
#pragma unroll 1
    for (int it = 0; it < 10; ++it) {
        LDS_WAIT();
        attn_stage(R, wl, lane);
        if (it < 9) attn_gload(R, Kb, VT, h, tokk, qh, it + 1, lane);
        LDS_WAIT();
        if (it < 8) attn_tile<false>(st, wl, qf, tab, tb0 + 31 * it + 32 * qh, 32 * qh + 4 * hh - cs, r32, hh);
        else        attn_tile<true>(st, wl, qf, tab, tb0 + 124 * (it - 8) + ecol0, ecol0 + 4 * hh - cs, r32, hh);
    }
    st.lrun += __shfl_xor(st.lrun, 32);
    const float inv = 1.0f / st.lrun;
    bf16* op = O + (size_t)tokq * 512 + h * 64 + 4 * hh;
    if (!dry)
#pragma unroll
    for (int g = 0; g < 4; ++g) {
        u32x2 w; w.x = pk2(st.o0[4 * g] * inv, st.o0[4 * g + 1] * inv); w.y = pk2(st.o0[4 * g + 2] * inv, st.o0[4 * g + 3] * inv); *(u32x2*)(op + 8 * g) = w;
        u32x2 w2; w2.x = pk2(st.o1[4 * g] * inv, st.o1[4 * g + 1] * inv); w2.y = pk2(st.o1[4 * g + 2] * inv, st.o1[4 * g + 3] * inv); *(u32x2*)(op + 32 + 8 * g) = w2;
    }
}

#define XB_TMO      128
#define XB_XCNT(j)  (256  + 64 * (j))
#define XB_XSUB(j)  (1280 + 64 * (j))
#define XB_XGEN(j)  (2304 + 64 * (j))
#define XB_TOP      3328
#define XB_TOPGEN   3392
#define XCD_BAR_WORDS 3456
#define XB_SPIN_CAP (1u << 18)

__device__ __forceinline__ unsigned xb_ld(unsigned* p)              { return __hip_atomic_load(p, __ATOMIC_RELAXED, __HIP_MEMORY_SCOPE_AGENT); }
__device__ __forceinline__ unsigned xb_add(unsigned* p, unsigned v) { return __hip_atomic_fetch_add(p, v, __ATOMIC_RELAXED, __HIP_MEMORY_SCOPE_AGENT); }
__device__ __forceinline__ unsigned xb_xcc_id() { return (unsigned)__builtin_amdgcn_s_getreg((3 << 11) | 20) & 0xFu; }
#define XB_SPIN(cond, bar) do { unsigned _sp = 0; while (cond) { __builtin_amdgcn_s_sleep(1); \
    if ((++_sp & 255u) == 0u) { if (xb_ld(&(bar)[XB_TMO])) break; if (_sp > XB_SPIN_CAP) { atomicAdd(&(bar)[XB_TMO], 1u); break; } } } } while (0)

struct XcdBarrier {
    unsigned* bar; unsigned x;
    volatile LAS unsigned* st;
};

__device__ __forceinline__ XcdBarrier xcd_barrier_post(unsigned* bar, volatile LAS unsigned* st) {
    XcdBarrier b; b.bar = bar; b.x = xb_xcc_id(); b.st = st;
    if (threadIdx.x == 0) (void)xb_add(&bar[XB_XCNT(b.x)], 1u);
    return b;
}
__device__ __forceinline__ void xcd_barrier_complete(unsigned* bar, unsigned x, unsigned& nloc, unsigned& nx) {
    const unsigned G = gridDim.x * gridDim.y * gridDim.z;
    unsigned sum, cnt, mine, sp = 0u;
    for (;;) {
        sum = 0u; cnt = 0u; mine = 0u;
#pragma unroll
        for (unsigned j = 0; j < 16; ++j) { const unsigned c = xb_ld(&bar[XB_XCNT(j)]); sum += c; cnt += (c > 0u) ? 1u : 0u; mine = (j == x) ? c : mine; }
        if (sum == G) break;
        __builtin_amdgcn_s_sleep(1);
        if ((++sp & 255u) == 0u) { if (xb_ld(&bar[XB_TMO])) break; if (sp > XB_SPIN_CAP) { atomicAdd(&bar[XB_TMO], 1u); break; } }
    }
    nloc = mine > 0u ? mine : 1u; nx = cnt > 0u ? cnt : 1u;
}

__device__ __forceinline__ void xcd_barrier(const XcdBarrier& b) {
    asm volatile("s_waitcnt vmcnt(0)" ::: "memory");
    __syncthreads();
    if (threadIdx.x == 0) {
        unsigned* bar = b.bar;
        __builtin_amdgcn_s_waitcnt(0);
        unsigned nloc = b.st[0], nx = b.st[1];
        if (nloc == 0u) { xcd_barrier_complete(bar, b.x, nloc, nx); b.st[0] = nloc; b.st[1] = nx; }
        const unsigned old = xb_add(&bar[XB_XSUB(b.x)], 1u);
        const unsigned gen = old / nloc;
        if (old + 1u == (gen + 1u) * nloc) {
            __builtin_amdgcn_fence(__ATOMIC_RELEASE, "agent");
            asm volatile("s_waitcnt vmcnt(0)" ::: "memory");
            const unsigned og = xb_add(&bar[XB_TOP], 1u);
            const unsigned tg = og / nx;
            if (og + 1u == (tg + 1u) * nx) xb_add(&bar[XB_TOPGEN], 1u);
            else XB_SPIN(xb_ld(&bar[XB_TOPGEN]) == tg, bar);
            __builtin_amdgcn_fence(__ATOMIC_ACQUIRE, "agent");
            xb_add(&bar[XB_XGEN(b.x)], 1u);
            asm volatile("s_waitcnt vmcnt(0)" ::: "memory");
        } else {
            XB_SPIN(xb_ld(&bar[XB_XGEN(b.x)]) == gen, bar);
            __builtin_amdgcn_fence(__ATOMIC_ACQUIRE, "agent");
            asm volatile("s_waitcnt vmcnt(0)" ::: "memory");
        }
    }
    __syncthreads();
}

__global__ void __launch_bounds__(512, 2) hybrid_fwd(Args args) {
    extern __shared__ __attribute__((aligned(16))) unsigned char lds_raw[];
    Frame F;
    F.lds = (LAS unsigned char*)lds_raw; F.tid = threadIdx.x; F.lane = F.tid & 63; F.wave = __builtin_amdgcn_readfirstlane(F.tid >> 6); F.G = gridDim.x; F.bid = blockIdx.x;
    F.xp = args.in[0]; F.xs = args.in[1];
    unsigned char* ws = args.ws; unsigned char* ob = (unsigned char*)args.out;
    float* SS0 = (float*)(ws + WS_CTL + CTL_SS0); float* SS1 = (float*)(ws + WS_CTL + CTL_SS1); float* SS2 = (float*)(ws + WS_CTL + CTL_SS2); float* F0 = (float*)(ws + WS_CTL + CTL_F0); unsigned* PCNT = (unsigned*)(ws + WS_CTL + CTL_CNT);
    bf16* WIN = (bf16*)(ws + WS_WIN); bf16* WBA = (bf16*)(ws + WS_WBA); bf16* WBH = (bf16*)(ws + WS_WBH); bf16* WO = (bf16*)(ws + WS_WO); bf16* WGU = (bf16*)(ws + WS_WGU); bf16* WD = (bf16*)(ws + WS_WD);
    bf16* XB = (bf16*)(ws + WS_XB); bf16* Qb = (bf16*)(ws + WS_Q); bf16* Kb = (bf16*)(ws + WS_K); bf16* VT = (bf16*)(ws + WS_VT);
    bf16* FRP = (bf16*)(ws + WS_FRP); bf16* FRS = (bf16*)(ws + WS_FRS); bf16* M1 = (bf16*)(ws + WS_M1); bf16* Hb = (bf16*)(ws + WS_H);
    bf16* HY = (bf16*)(ob + OUT_HY); bf16* UT = (bf16*)(ob + OUT_UT); bf16* M2 = (bf16*)(ob + OUT_M2);
    const int lo = args.ph_lo, hi = args.ph_hi;
    const int gw = F.bid * 8 + F.wave, NGW = F.G * 8;
    volatile LAS unsigned* bar_st = (volatile LAS unsigned*)(F.lds + LDS_BYTES - 64);
    if (F.tid < 2) bar_st[F.tid] = 0u;
    __syncthreads();
    XcdBarrier xbar = xcd_barrier_post((unsigned*)(ws + WS_CTL + CTL_BAR), bar_st);
    if (lo > hi) { asm volatile("s_waitcnt vmcnt(0)" ::: "memory"); cg::this_grid().sync(); }
#ifndef PHASE_MASK
#define PHASE_MASK 0xfff
#endif
#define IN(k) (((PHASE_MASK >> (k)) & 1) && lo <= (k) && (k) < hi)
#define GRIDSYNC() do { asm volatile("s_waitcnt vmcnt(0)" ::: "memory"); cg::this_grid().sync(); } while (0)
#define XSYNC() xcd_barrier(xbar)
#ifdef PROBE_DUP
#define DUP_BEGIN(k) { const bool dry = args.dry != 0; const int sub = args.dry ? args.sub : 3; (void)sub;
#define DUP_END(k) }
#else
#define DUP_BEGIN(k) { constexpr bool dry = false; constexpr int sub = 3; (void)sub;
#define DUP_END(k) }
#endif
#define SEAM(k) do { if (IN(k) && IN((k) + 1)) XSYNC(); } while (0)

    DUP_BEGIN(0) if (IN(0)) {
        LAS float* scr = (LAS float*)(F.lds + F.wave * 16384);
        const float* nmix = args.in[2]; const float* nffn = args.in[19];
        constexpr int I_IN = 16 * 160, I_BR = 8 * 32, I_O = 16 * 32, I_G = 16 * 88, I_D = 44 * 32;
        constexpr int NITEMS = I_IN + 2 * I_BR + I_O + 2 * I_G + I_D;
        if (sub & 1) for (int it = gw; it < NITEMS; it += NGW) {
            int r = it;
            if (r < I_IN) { p0_transpose_item(args.in[3], 1024, 5120, WIN, nmix, 0, scr, r, F.lane); continue; } r -= I_IN;
            if (r < I_BR) { p0_transpose_item(args.in[16], 512, 1024, WBA, nullptr, 0, scr, r, F.lane); continue; } r -= I_BR;
            if (r < I_BR) { p0_transpose_item(args.in[17], 512, 1024, WBH, nullptr, 0, scr, r, F.lane); continue; } r -= I_BR;
            if (r < I_O) { p0_transpose_item(args.in[18], 1024, 1024, WO, nullptr, 0, scr, r, F.lane); continue; } r -= I_O;
            if (r < I_G) { p0_transpose_item(args.in[20], 1024, DFF, WGU, nffn, 1, scr, r, F.lane); continue; } r -= I_G;
            if (r < I_G) { p0_transpose_item(args.in[21], 1024, DFF, WGU, nffn, 2, scr, r, F.lane); continue; } r -= I_G;
            p0_transpose_item(args.in[22], DFF, 1024, WD, nullptr, 0, scr, r, F.lane);
        }
        if (sub & 2) for (int m = gw; m < MTOK; m += 4 * NGW) {
            f32x4 v[4][4];
#pragma unroll
            for (int q = 0; q < 4; ++q) { const f32x4* xr = (const f32x4*)xrow(F, m + q * NGW) + F.lane;
#pragma unroll
                for (int j = 0; j < 4; ++j) v[q][j] = xr[64 * j]; }
#pragma unroll
            for (int q = 0; q < 4; ++q) { float s = 0.f;
#pragma unroll
                for (int j = 0; j < 4; ++j) s += (v[q][j].x * v[q][j].x + v[q][j].y * v[q][j].y) + (v[q][j].z * v[q][j].z + v[q][j].w * v[q][j].w);
                s = wave_sum(s); if (F.lane == 0) SS0[m + q * NGW] = s;
                u32x2* o8 = (u32x2*)(XB + (size_t)(m + q * NGW) * DM) + F.lane;
#pragma unroll
                for (int j = 0; j < 4; ++j) { u32x2 w; w.x = pk2(v[q][j].x, v[q][j].y); w.y = pk2(v[q][j].z, v[q][j].w); o8[64 * j] = w; } }
        }
        for (int i = F.bid * 512 + F.tid; i < 2 * MTOK; i += F.G * 512) SS1[i] = 0.f;
        if (F.bid == 0) for (int i = F.tid; i < 2048; i += 512) PCNT[i] = 0u;
        __syncthreads();
        if (sub == 3 || (sub & 4)) filter_stage_weights(F, args.in[7], args.in[8], args.in[9], args.in[10], args.in[11], args.in[12], args.in[14]);
        if (sub == 3 || (sub & 4)) for (int fu = F.bid; fu < 320; fu += F.G) {
            if (fu < 256) filter_unit(F, 16384, 64 * fu, FRS, F0 + 1024, args.in[13]);
            else filter_unit(F, 4096, 64 * (fu - 256), FRP, F0, args.in[13]);
        }
    }
    DUP_END(0)
    SEAM(0);
    DUP_BEGIN(1) if (IN(1)) {
        pg8::Gemm g{XB, WIN, MTOK, NIN1, DM}; pg8::StaticOrder S; S.init(MTOK, NIN1, F.G, F.bid);
        EpiIn E{Qb, Kb, VT, HY, SS0};
        pg8::gemm_phase<EpiIn, pg8::StaticOrder, true, true>(F.lds, g, S, E);
    }
    DUP_END(1)
    SEAM(1);
    DUP_BEGIN(2) if (IN(2)) { for (int u = F.bid; u < 2048; u += F.G) p2b_unit(F, u, HY, UT, args.in[5], args.in[6]); }
    DUP_END(2)
    SEAM(2);
    DUP_BEGIN(3) if (IN(3)) {
        if (sub & 1) for (int cu = F.bid; cu < 1024; cu += F.G) {
            if (cu < 512) conv_unit<16384, 1>(F, cu, FRS, F0 + 1024, args.in[15], UT, UT, TOKP, dry);
            else conv_unit<4096, 4>(F, cu - 512, FRP, F0, args.in[15], UT, UT, 0, dry);
        }
        __syncthreads();
        int cur_head = -1; LAS float* tab = (LAS float*)(F.lds + F.wave * 2560); LAS unsigned char* wl = F.lds + 20480 + F.wave * ATT_WAVE_LDS;
        if (sub & 2) {
            if ((F.G & 7) == 0) {
                const int h = F.bid & 7, NWV = (F.G >> 3) * 8;
                for (int e = (F.bid >> 3) * 8 + F.wave; e < 1024; e += NWV)
                    attn_unit(e >> 1, h, e & 1, Qb, Kb, VT, Qb, args.in[4], tab, wl, F.lane, cur_head, dry);
            } else {
                for (int u = gw; u < 8192; u += NGW) attn_unit(u >> 4, (u >> 1) & 7, u & 1, Qb, Kb, VT, Qb, args.in[4], tab, wl, F.lane, cur_head, dry);
            }
        }
    }
    DUP_END(3)
    SEAM(3);
    DUP_BEGIN(4) if (IN(4)) { for (int u = F.bid; u < 2048; u += F.G) p2d_unit(F, u, HY, UT, Kb, args.in[5], args.in[6]); }
    DUP_END(4)
    SEAM(4);
    DUP_BEGIN(5) if (IN(5)) {
        pg8::StaticOrder S; S.init(MTOK, DM, F.G, F.bid);
        { pg8::Gemm g{XB, WIN + (size_t)3072 * DM, MTOK, DM, DM}; EpiGate E{M1, SS0}; pg8::gemm_phase<EpiGate, pg8::StaticOrder, true, true>(F.lds, g, S, E); }
        { pg8::Gemm g{Qb, WBA, MTOK, DM, 512}; EpiMix<0> E{M1, nullptr}; pg8::gemm_phase<EpiMix<0>, pg8::StaticOrder, true, true>(F.lds, g, S, E); }
        { pg8::Gemm g{XB, WIN + (size_t)4096 * DM, MTOK, DM, DM}; EpiGate E{M2, SS0}; pg8::gemm_phase<EpiGate, pg8::StaticOrder, true, true>(F.lds, g, S, E); }
        { pg8::Gemm g{Kb, WBH, MTOK, DM, 512}; EpiMix<1> E{M1, M2}; pg8::gemm_phase<EpiMix<1>, pg8::StaticOrder, true, true>(F.lds, g, S, E); }
    }
    DUP_END(5)
    SEAM(5);
    DUP_BEGIN(6) if (IN(6)) {
        pg8::Gemm g{M1, WO, MTOK, DM, DM}; pg8::StaticOrder S; S.init(MTOK, DM, F.G, F.bid);
        EpiRes<true, false> E{F.xp, F.xs, args.out, XB, SS1, 0, dry, nullptr, nullptr};
        pg8::gemm_phase<EpiRes<true, false>, pg8::StaticOrder, true, true>(F.lds, g, S, E);
    }
    DUP_END(6)
    SEAM(6);
#define FFN_HALF(hf) \
    DUP_BEGIN(7 + 2 * (hf)) if (IN(7 + 2 * (hf))) { \
        pg8::Gemm g{XB + (size_t)(hf) * TOKP * DM, WGU, TOKP, 2 * DFF, DM}; pg8::StaticOrder S; S.init(TOKP, 2 * DFF, F.G, F.bid); \
        EpiSwiglu E{Hb, SS1 + (hf) * TOKP}; \
        pg8::gemm_phase<EpiSwiglu, pg8::StaticOrder, true, true>(F.lds, g, S, E); \
    } DUP_END(7 + 2 * (hf)) \
    SEAM(7 + 2 * (hf)); \
    DUP_BEGIN(8 + 2 * (hf)) if (IN(8 + 2 * (hf))) { \
        pg8::Gemm g{Hb, WD, TOKP, DM, DFF}; pg8::StaticOrder S; S.init(TOKP, DM, F.G, F.bid); \
        EpiRes<false, true> E{nullptr, nullptr, args.out, XB, SS2, (hf) * TOKP, dry, args.in[23], PCNT}; \
        pg8::gemm_phase<EpiRes<false, true>, pg8::StaticOrder, true, true>(F.lds, g, S, E); \
    } DUP_END(8 + 2 * (hf)) \
    SEAM(8 + 2 * (hf));
    FFN_HALF(0)
    FFN_HALF(1)
#undef FFN_HALF
    DUP_BEGIN(11) if (IN(11)) {
        const float* nf = args.in[23];
        for (int m = gw; m < MTOK; m += NGW) {
            const float rs = rsqrtf(SS2[m] * (1.0f / DM) + EPSN);
            f32x4* xr = (f32x4*)(args.out + (size_t)m * DM) + F.lane;
#pragma unroll
            for (int j = 0; j < 4; ++j) { const f32x4 g4 = *((const f32x4*)nf + F.lane + 64 * j); const f32x4 o4 = xr[64 * j] * rs * g4; if (!dry) xr[64 * j] = o4; }
        }
    } DUP_END(11)
#undef IN
#undef SEAM
}

extern "C" void kernel_launch(void* const* d_in, const int* in_sizes, int n_in, void* d_out, int out_size, void* d_ws, size_t ws_size, hipStream_t stream) {
    static int grid = 0;
    if (grid == 0) {
        if (n_in != 24 || out_size != 2 * TOKP * DM || ws_size < WS_END) { fprintf(stderr, "kernel_launch: unexpected shapes (n_in %d out %d ws %zu)\n", n_in, out_size, ws_size); grid = -1; return; }
        int dev = 0, cus = 0, per_cu = 0;
        if (hipGetDevice(&dev) != hipSuccess || hipDeviceGetAttribute(&cus, hipDeviceAttributeMultiprocessorCount, dev) != hipSuccess) { grid = -1; return; }
        if (hipFuncSetAttribute((const void*)hybrid_fwd, hipFuncAttributeMaxDynamicSharedMemorySize, LDS_BYTES) != hipSuccess) { fprintf(stderr, "kernel_launch: hipFuncSetAttribute failed\n"); grid = -1; return; }
        if (hipOccupancyMaxActiveBlocksPerMultiprocessor(&per_cu, (const void*)hybrid_fwd, 512, LDS_BYTES) != hipSuccess || per_cu < 1) { fprintf(stderr, "kernel_launch: occupancy query says %d\n", per_cu); per_cu = 1; }
        (void)hipGetLastError();
        grid = cus * 1;
        if (grid > 256) grid = 256;
    }
    if (grid < 0) return;
    if (hipMemsetAsync((char*)d_ws + WS_CTL + CTL_BAR, 0, CTL_BAR_BYTES, stream) != hipSuccess) { fprintf(stderr, "kernel_launch: memset of barrier words failed\n"); return; }
    Args a{};
    for (int i = 0; i < 24; ++i) a.in[i] = (const float*)d_in[i];
    a.out = (float*)d_out; a.ws = (unsigned char*)d_ws;
#if MK_N_LAUNCHES == 1
    a.ph_lo = 0; a.ph_hi = NPH;
    void* kargs[] = {&a};
    hipError_t e = hipLaunchCooperativeKernel((const void*)hybrid_fwd, dim3(grid), dim3(512), kargs, LDS_BYTES, stream);
    if (e != hipSuccess) fprintf(stderr, "cooperative launch failed: %s (grid %d)\n", hipGetErrorString(e), grid);
#else
    for (int ph = 0; ph < NPH; ++ph) { a.ph_lo = ph; a.ph_hi = ph + 1;
#ifdef PROBE_DUP
        if (ph == PROBE_DUP) { a.dry = 1; a.sub = PROBE_SUB; hipLaunchKernelGGL(hybrid_fwd, dim3(grid), dim3(512), LDS_BYTES, stream, a); a.dry = 0; }
#endif
        hipLaunchKernelGGL(hybrid_fwd, dim3(grid), dim3(512), LDS_BYTES, stream, a); }
#endif
}
```
